# Optimizing an MI355X kernel written in HIP

```python
import math
import jax, jax.numpy as jnp
from jax import lax
import numpy as np

D_MODEL = 1024
BATCH = 2
SEQ = 16384
DEPTH = 2

CTX_LEN = 256
GRID_W = 64
N_MIXERS = 2
DA_HEADS = 8
DA_HEAD_DIM = 64
DA_V_DIM = 2 * DA_HEAD_DIM
DA_QK_WIDTH = DA_HEADS * 2 * DA_HEAD_DIM
DA_V_WIDTH = DA_HEADS * DA_V_DIM
Q_BLOCK = 128
ROPE_BASE = 10000.0
ROPE_FREQS = DA_HEAD_DIM // 4
GM_CHUNK = 128
GM_HALF = 2 * D_MODEL
GM_GROUPS = 8
GM_GROUP_DIM = GM_HALF // GM_GROUPS
FFN_DIM = 2816
N_EXPERTS = 8
TOP_K = 2
EXPERT_DIM = 3584
EPS = 1e-6
N_ATTN_LAYERS = (DEPTH + 1) // 2
N_GMLP_LAYERS = DEPTH // 2

kernel_name = 'hybrid_diffattn_chunkgmlp_moe_dit'


def rmsnorm(x, w):
    xf = x.astype(jnp.float32)
    y = xf * lax.rsqrt(jnp.mean(xf * xf, axis=-1, keepdims=True) + EPS)
    return (y * w).astype(x.dtype)


def layernorm(x, w, b):
    xf = x.astype(jnp.float32)
    mu = jnp.mean(xf, axis=-1, keepdims=True)
    xc = xf - mu
    y = xc * lax.rsqrt(jnp.mean(xc * xc, axis=-1, keepdims=True) + EPS)
    return (y * w + b).astype(x.dtype)


def ada(cond, w_mod, b_mod):
    m = jax.nn.silu(cond) @ w_mod + b_mod
    return jnp.split(m, 6, axis=-1)


def modulate(h, shift, scale):
    return h * (1.0 + scale) + shift


def rope_axis(x, ang):
    x1, x2 = jnp.split(x, 2, axis=-1)
    cs = jnp.cos(ang)[None, :, None, None, :]
    sn = jnp.sin(ang)[None, :, None, None, :]
    return jnp.concatenate([x1 * cs - x2 * sn, x1 * sn + x2 * cs], axis=-1).astype(x.dtype)


def rope2d(x, ang_row, ang_col):
    xr, xcl = jnp.split(x, 2, axis=-1)
    return jnp.concatenate([rope_axis(xr, ang_row), rope_axis(xcl, ang_col)], axis=-1)


def diff_attention(h, hc, w_qkv, w_o, lq1, lk1, lq2, lk2, subln_w, lam_init, ang_row, ang_col, ctx_out):
    B, S, _ = h.shape
    L = hc.shape[1]
    qkv = h @ w_qkv
    q = qkv[..., :DA_QK_WIDTH].reshape(B, S, DA_HEADS, 2, DA_HEAD_DIM)
    k = qkv[..., DA_QK_WIDTH:2 * DA_QK_WIDTH].reshape(B, S, DA_HEADS, 2, DA_HEAD_DIM)
    v = qkv[..., 2 * DA_QK_WIDTH:].reshape(B, S, DA_HEADS, DA_V_DIM)
    q = rope2d(q, ang_row, ang_col)
    k = rope2d(k, ang_row, ang_col)
    if ctx_out:
        qkv_c = hc @ w_qkv
        qc = qkv_c[..., :DA_QK_WIDTH].reshape(B, L, DA_HEADS, 2, DA_HEAD_DIM)
        kv_c = qkv_c[..., DA_QK_WIDTH:]
    else:
        kv_c = hc @ w_qkv[:, DA_QK_WIDTH:]
    kc = kv_c[..., :DA_QK_WIDTH].reshape(B, L, DA_HEADS, 2, DA_HEAD_DIM)
    vc = kv_c[..., DA_QK_WIDTH:].reshape(B, L, DA_HEADS, DA_V_DIM)
    lam = (jnp.exp(jnp.sum(lq1.astype(jnp.float32) * lk1.astype(jnp.float32)))
           - jnp.exp(jnp.sum(lq2.astype(jnp.float32) * lk2.astype(jnp.float32))) + lam_init)
    scale = DA_HEAD_DIM ** -0.5

    def attend(qb, keys, vals):
        s = jnp.einsum('bqhcd,bkhcd->bhcqk', qb, keys).astype(jnp.float32) * scale
        p = jax.nn.softmax(s, axis=-1)
        a = p[:, :, 0] - lam * p[:, :, 1]
        return jnp.einsum('bhqk,bkhv->bqhv', a.astype(vals.dtype), vals)

    k_all = jnp.concatenate([kc, k], axis=1)
    v_all = jnp.concatenate([vc, v], axis=1)
    n_blk = S // Q_BLOCK
    qb = q.reshape(B, n_blk, Q_BLOCK, DA_HEADS, 2, DA_HEAD_DIM).swapaxes(0, 1)
    o = lax.map(lambda blk: attend(blk, k_all, v_all), qb)
    o = o.swapaxes(0, 1).reshape(B, S, DA_HEADS, DA_V_DIM)

    def finish(out):
        out = rmsnorm(out, subln_w) * (1.0 - lam_init)
        return out.reshape(out.shape[0], out.shape[1], DA_V_WIDTH) @ w_o

    y = finish(o)
    yc = finish(attend(qc, kc, vc)) if ctx_out else None
    return y, yc


def chunk_gmlp(h, w_in, vn_w, vn_b, w_s, b_s, w_out):
    B, L, _ = h.shape
    z = jax.nn.gelu(h @ w_in, approximate=False)
    u, v = z[..., :GM_HALF], z[..., GM_HALF:]
    v = layernorm(v, vn_w, vn_b)
    v = v.reshape(B, L // GM_CHUNK, GM_CHUNK, GM_GROUPS, GM_GROUP_DIM)
    s = jnp.einsum('gpq,bnqgc->bnpgc', w_s, v) + b_s.T[:, :, None]
    return (u * s.reshape(B, L, GM_HALF)) @ w_out


def swiglu(h, wg, wu, wd):
    return (jax.nn.silu(h @ wg) * (h @ wu)) @ wd


def moe_ffn(h, w_router, wg, wu, wd):
    logits = (h @ w_router).astype(jnp.float32)
    top_v, top_i = lax.top_k(logits, TOP_K)
    gates = jax.nn.softmax(top_v, axis=-1)
    y = jnp.zeros_like(h)
    for e in range(N_EXPERTS):
        g_e = jnp.sum(jnp.where(top_i == e, gates, 0.0), axis=-1, keepdims=True).astype(h.dtype)
        y = y + g_e * swiglu(h, wg[e], wu[e], wd[e])
    return y


def setup_inputs(seed: int = 0) -> dict:
    key = jax.random.key(seed)
    ks = jax.random.split(key, 32)
    f32 = jnp.float32
    D = D_MODEL

    def nrm(k, shape, s):
        return jax.random.normal(k, shape, f32) * s

    def gain(k, shape):
        return 1.0 + 0.02 * jax.random.normal(k, shape, f32)

    return {
        'x': nrm(ks[0], (BATCH, SEQ, D), 1.0),
        'c': nrm(ks[1], (BATCH, D), 1.0),
        'ctx': nrm(ks[2], (BATCH, CTX_LEN, D), 1.0),
        'c_ctx': nrm(ks[3], (D,), 1.0),
        'w_mod': nrm(ks[4], (DEPTH, D, 6 * D), 0.5 * D ** -0.5),
        'b_mod': nrm(ks[5], (DEPTH, 6 * D), 0.02),
        'norm1_w': gain(ks[6], (DEPTH, D)),
        'norm2_w': gain(ks[7], (DEPTH, D)),
        'final_norm_w': gain(ks[8], (D,)),
        'da_w_qkv': nrm(ks[9], (N_ATTN_LAYERS, D, 2 * DA_QK_WIDTH + DA_V_WIDTH), D ** -0.5),
        'da_w_o': nrm(ks[10], (N_ATTN_LAYERS, DA_V_WIDTH, D), DA_V_WIDTH ** -0.5),
        'da_lambda_q1': nrm(ks[11], (N_ATTN_LAYERS, DA_HEAD_DIM), 0.1),
        'da_lambda_k1': nrm(ks[12], (N_ATTN_LAYERS, DA_HEAD_DIM), 0.1),
        'da_lambda_q2': nrm(ks[13], (N_ATTN_LAYERS, DA_HEAD_DIM), 0.1),
        'da_lambda_k2': nrm(ks[14], (N_ATTN_LAYERS, DA_HEAD_DIM), 0.1),
        'da_subln_w': gain(ks[15], (N_ATTN_LAYERS, DA_V_DIM)),
        'gm_w_in': nrm(ks[16], (N_GMLP_LAYERS, D, 2 * GM_HALF), D ** -0.5),
        'gm_vnorm_w': gain(ks[17], (N_GMLP_LAYERS, GM_HALF)),
        'gm_vnorm_b': nrm(ks[18], (N_GMLP_LAYERS, GM_HALF), 0.02),
        'gm_w_s': nrm(ks[19], (N_GMLP_LAYERS, GM_GROUPS, GM_CHUNK, GM_CHUNK), GM_CHUNK ** -0.5),
        'gm_b_s': gain(ks[20], (N_GMLP_LAYERS, GM_GROUPS, GM_CHUNK)),
        'gm_w_out': nrm(ks[21], (N_GMLP_LAYERS, GM_HALF, D), GM_HALF ** -0.5),
        'ffn_w_gate': nrm(ks[22], (N_ATTN_LAYERS, D, FFN_DIM), D ** -0.5),
        'ffn_w_up': nrm(ks[23], (N_ATTN_LAYERS, D, FFN_DIM), D ** -0.5),
        'ffn_w_down': nrm(ks[24], (N_ATTN_LAYERS, FFN_DIM, D), FFN_DIM ** -0.5),
        'moe_w_router': nrm(ks[25], (N_GMLP_LAYERS, D, N_EXPERTS), D ** -0.5),
        'moe_w_gate': nrm(ks[26], (N_GMLP_LAYERS, N_EXPERTS, D, EXPERT_DIM), D ** -0.5),
        'moe_w_up': nrm(ks[27], (N_GMLP_LAYERS, N_EXPERTS, D, EXPERT_DIM), D ** -0.5),
        'moe_w_down': nrm(ks[28], (N_GMLP_LAYERS, N_EXPERTS, EXPERT_DIM, D), EXPERT_DIM ** -0.5),
    }


def reference(x, c, ctx, c_ctx, w_mod, b_mod, norm1_w, norm2_w, final_norm_w,
              da_w_qkv, da_w_o, da_lambda_q1, da_lambda_k1, da_lambda_q2, da_lambda_k2, da_subln_w,
              gm_w_in, gm_vnorm_w, gm_vnorm_b, gm_w_s, gm_b_s, gm_w_out,
              ffn_w_gate, ffn_w_up, ffn_w_down,
              moe_w_router, moe_w_gate, moe_w_up, moe_w_down):
    n_tok = x.shape[1]
    rows = n_tok // GRID_W
    row = jnp.broadcast_to(jnp.arange(rows, dtype=jnp.float32)[:, None], (rows, GRID_W)).reshape(-1)
    col = jnp.broadcast_to(jnp.arange(GRID_W, dtype=jnp.float32)[None, :], (rows, GRID_W)).reshape(-1)
    inv_freq = ROPE_BASE ** (-jnp.arange(ROPE_FREQS, dtype=jnp.float32) / ROPE_FREQS)
    ang_row = row[:, None] * inv_freq
    ang_col = col[:, None] * inv_freq

    xc = ctx
    for i in range(DEPTH):
        j = i // 2
        is_attn = (i % N_MIXERS == 0)
        ctx_out = any(l % N_MIXERS == 0 for l in range(i + 1, DEPTH))
        sh1, sc1, g1, sh2, sc2, g2 = ada(c[:, None, :], w_mod[i], b_mod[i])
        csh1, csc1, cg1, csh2, csc2, cg2 = ada(c_ctx, w_mod[i], b_mod[i])
        h = modulate(rmsnorm(x, norm1_w[i]), sh1, sc1)
        if is_attn or ctx_out:
            hc = modulate(rmsnorm(xc, norm1_w[i]), csh1, csc1)
        if is_attn:
            lam_init = 0.8 - 0.6 * math.exp(-0.3 * i)
            y, yc = diff_attention(h, hc, da_w_qkv[j], da_w_o[j], da_lambda_q1[j], da_lambda_k1[j],
                                   da_lambda_q2[j], da_lambda_k2[j], da_subln_w[j], lam_init,
                                   ang_row, ang_col, ctx_out)
        else:
            gm = (gm_w_in[j], gm_vnorm_w[j], gm_vnorm_b[j], gm_w_s[j], gm_b_s[j], gm_w_out[j])
            y = chunk_gmlp(h, *gm)
            yc = chunk_gmlp(hc, *gm) if ctx_out else None
        x = x + g1 * y
        if ctx_out:
            xc = xc + cg1 * yc

        if i % 2 == 0:
            ffn = lambda t: swiglu(t, ffn_w_gate[j], ffn_w_up[j], ffn_w_down[j])
        else:
            ffn = lambda t: moe_ffn(t, moe_w_router[j], moe_w_gate[j], moe_w_up[j], moe_w_down[j])
        h = modulate(rmsnorm(x, norm2_w[i]), sh2, sc2)
        x = x + g2 * ffn(h)
        if ctx_out:
            hc = modulate(rmsnorm(xc, norm2_w[i]), csh2, csc2)
            xc = xc + cg2 * ffn(hc)
    return rmsnorm(x, final_norm_w)
```

```cpp
#include <hip/hip_runtime.h>
#include <hip/hip_bf16.h>
#include <cstdio>
#include <cstdint>
#include <cmath>

#ifndef MK_N_LAUNCHES
#define MK_N_LAUNCHES 1
#endif

constexpr int BATCH = 2, SEQ = 16384, DM = 1024, T = BATCH * SEQ, CTXL = 256, SK = CTXL + SEQ;
constexpr int NH = 8, FFN = 2816, GMH = 2048, NE = 8, EXD = 3584;
constexpr float EPS = 1e-6f;
constexpr float LAM_INIT = 0.2f;
constexpr float H8SCALE = 2.0f;
constexpr float W8SCALE = 64.0f;
constexpr float QSCALE = 0.125f * 1.4426950408889634f;

namespace pg8 {
#define PG8_LAS __attribute__((address_space(3)))
typedef unsigned short bf16_t;
typedef short bf16x8 __attribute__((ext_vector_type(8)));
typedef float f32x4 __attribute__((ext_vector_type(4)));
typedef float f32x2 __attribute__((ext_vector_type(2)));
typedef unsigned u32x4 __attribute__((ext_vector_type(4)));
constexpr int BM = 256, BK = 64, HALF = 128, HTB = HALF * BK * 2, STAGE_BYTES = 8 * HTB, NXCD = 8, WGM = 8;

__host__ __device__ __forceinline__ int lds_byte(int r, int c) { const int st = (r >> 4) * 2 + (c >> 5), rr = r & 15, cc = c & 31, ob = rr * 64 + cc * 2; return st * 1024 + (ob ^ (((ob >> 9) & 1) << 5)); }
__host__ __device__ __forceinline__ void stage_rc(int b, int& R, int& C) { const int st = b / 1024, sb = b % 1024, swz = sb ^ (((sb >> 9) & 1) << 5); R = (st >> 1) * 16 + swz / 64; C = (st & 1) * 32 + (swz % 64) / 2; }
__host__ __device__ __forceinline__ int perm32(int rho) { const int n = rho >> 4, i = rho & 15; return 8 * (i >> 2) + 4 * n + (i & 3); }

struct Unit { int pm, pn, pb; };
struct Gemm { const bf16_t* A; const bf16_t* Bt; int lda, ldb, K; };

__device__ __forceinline__ void map_unit(int wgid, int nM, int nN, int& pm, int& pn) {
    const int nwg = nM * nN;
    { const int q = nwg / NXCD, r = nwg % NXCD, xcd = wgid % NXCD, off = wgid / NXCD; wgid = (xcd < r ? xcd * (q + 1) : r * (q + 1) + (xcd - r) * q) + off; }
    const int nig = WGM * nN, gid = wgid / nig, fm = gid * WGM, gsz = (nM - fm) < WGM ? (nM - fm) : WGM;
    pm = fm + ((wgid % nig) % gsz); pn = (wgid % nig) / gsz;
}
struct StaticOrder {
    int nM, nN, nwg, G, c;
    __device__ __forceinline__ void init(int nM_, int nN_, int G_, int c_) { nM = nM_; nN = nN_; nwg = nM * nN; G = G_; c = c_; }
    __device__ __forceinline__ bool next(int i, Unit& u) const {
        const long L = (long)i * G + c; if (L >= nwg) return false;
        map_unit((int)L, nM, nN, u.pm, u.pn); u.pb = u.pn; return true;
    }
};
struct MoeOrder {
    int nM, nN, nwg, G, c, p0, nBusy, skipR; const int* panel_e; bool keepGlobal;
    __device__ __forceinline__ void init(int nM_, int nN_, int G_, int c_, int p0_, const int* pe, bool kg, int nBusy_ = 0, int skipR_ = 0) { nM = nM_; nN = nN_; nwg = nM * nN; G = G_; c = c_; p0 = p0_; panel_e = pe; keepGlobal = kg; nBusy = nBusy_; skipR = nBusy_ > 0 ? skipR_ : 0; }
    __device__ __forceinline__ bool next(int i, Unit& u) const {
        long L;
        if (skipR == 0) L = (long)i * G + c;
        else { const int Gp = G - nBusy;
            if (c >= nBusy) L = i < skipR ? (long)i * Gp + (c - nBusy) : (long)skipR * Gp + (long)(i - skipR) * G + c;
            else L = (long)skipR * Gp + (long)i * G + c; }
        if (L >= nwg) return false;
        int pm, pn; map_unit((int)L, nM, nN, pm, pn);
        const int e = __builtin_amdgcn_readfirstlane(panel_e[p0 + pm]);
        u.pm = keepGlobal ? p0 + pm : pm; u.pn = pn; u.pb = e * nN + pn; return true;
    }
};

__device__ __forceinline__ unsigned cvt_pk_bf16(float lo, float hi) { unsigned r; asm volatile("v_cvt_pk_bf16_f32 %0, %1, %2" : "=v"(r) : "v"(lo), "v"(hi)); return r; }
__device__ __forceinline__ f32x2 gelu_pk(f32x2 v) {
    const f32x2 av = __builtin_elementwise_abs(v);
    f32x2 p = av * 5.62129966396221e-06f + 5.105520900865985e-05f; p = p * av + 3.968613701101391e-05f; p = p * av + 0.003422739238900825f; p = p * av + 0.022076998456581717f;
    p = p * av + 0.052075163036630574f; p = p * av + 1.0442737824274138f;
    p = p * p; p = p * p; p = p * p; p = p * p;
    f32x2 h; h.x = __builtin_amdgcn_rcpf(p.x); h.y = __builtin_amdgcn_rcpf(p.y);
    const f32x2 m = v * h, r = v - m;
    f32x2 o; o.x = v.x < 0.f ? m.x : r.x; o.y = v.y < 0.f ? m.y : r.y; return o;
}
__device__ __forceinline__ float silu_f(float g) { return g * __builtin_amdgcn_rcpf(1.0f + __builtin_amdgcn_exp2f(-1.4426950408889634f * g)); }

struct EpiQKV {
    static constexpr bool PERM = true;
    bf16_t *Q, *K, *V; const float* cs; const float* sn;
    __device__ __forceinline__ void operator()(const f32x4 (&acc)[2][2][4][2], const Unit& u, int wr, int wc, int fr, int fq) const {
        const int sect = u.pn >> 2, cin = (u.pn & 3) * 256; const bool isctx = u.pm >= 128;
        if (isctx && sect == 0) return;
        int b, t0; if (!isctx) { b = u.pm >> 6; t0 = (u.pm & 63) * 256; } else { b = u.pm - 128; t0 = 0; }
        bf16_t* base; size_t rowbase;
        if (sect == 0) { base = Q; rowbase = (size_t)u.pm * 256; } else { base = sect == 1 ? K : V; rowbase = (size_t)b * SK + (isctx ? 0 : CTXL + t0); }
        const bool rope = (sect < 2) && !isctx; const float sc = sect == 0 ? QSCALE : 1.0f;
        const int col0 = cin + wc * 32 + 8 * fq, axis = wc & 1;
#pragma unroll
        for (int ai = 0; ai < 2; ++ai)
#pragma unroll
            for (int m = 0; m < 4; ++m) {
                const int r = wr * 64 + ai * HALF + m * 16 + fr, t = t0 + r;
                f32x4 c4 = (f32x4){1.f, 1.f, 1.f, 1.f}, s4 = (f32x4){0.f, 0.f, 0.f, 0.f};
                if (rope) { const int pos = axis ? (t & 63) : (t >> 6); c4 = *(const f32x4*)(cs + pos * 16 + 4 * fq); s4 = *(const f32x4*)(sn + pos * 16 + 4 * fq); }
                bf16_t* rowp = base + (rowbase + r) * DM + col0;
#pragma unroll
                for (int bj = 0; bj < 2; ++bj) {
                    const f32x4 v0 = acc[ai][bj][m][0], v1 = acc[ai][bj][m][1];
                    const f32x4 o0 = (v0 * c4 - v1 * s4) * sc, o1 = (v0 * s4 + v1 * c4) * sc;
                    u32x4 w; w.x = cvt_pk_bf16(o0[0], o0[1]); w.y = cvt_pk_bf16(o0[2], o0[3]); w.z = cvt_pk_bf16(o1[0], o1[1]); w.w = cvt_pk_bf16(o1[2], o1[3]);
                    *(u32x4*)(rowp + bj * HALF) = w; }
            }
    }
};
struct EpiRes {
    static constexpr bool PERM = false;
    const float* xin; float* out; const float* gate;
    int gstride;
    __device__ __forceinline__ void operator()(const f32x4 (&acc)[2][2][4][2], const Unit& u, int wr, int wc, int fr, int fq) const {
        const int b = u.pm >> 6, col0 = u.pn * BM + wc * 32 + 4 * fq; const float* g = gate + (size_t)b * gstride + col0;
        f32x4 gv[2][2];
#pragma unroll
        for (int bj = 0; bj < 2; ++bj)
#pragma unroll
            for (int n = 0; n < 2; ++n) gv[bj][n] = *(const f32x4*)(g + bj * HALF + n * 16);
#pragma unroll
        for (int ai = 0; ai < 2; ++ai)
#pragma unroll
            for (int m = 0; m < 4; ++m) { const size_t off = (size_t)(u.pm * BM + ai * HALF + wr * 64 + m * 16 + fr) * DM + col0;
#pragma unroll
                for (int bj = 0; bj < 2; ++bj)
#pragma unroll
                    for (int n = 0; n < 2; ++n) { const f32x4 xi = *(const f32x4*)(xin + off + bj * HALF + n * 16); *(f32x4*)(out + off + bj * HALF + n * 16) = xi + gv[bj][n] * acc[ai][bj][m][n]; }
                if (m & 1) asm volatile("" ::: "memory"); }
    }
};
template <bool OUT8> struct EpiSwiGLUT {
    static constexpr bool PERM = true;
    bf16_t* H; int ldh, pm0; float sc; float osc;
    __device__ __forceinline__ void operator()(const f32x4 (&acc)[2][2][4][2], const Unit& u, int wr, int wc, int fr, int fq) const {
        const int col0 = u.pn * HALF + wc * 32 + 8 * fq;
#pragma unroll
        for (int ai = 0; ai < 2; ++ai)
#pragma unroll
            for (int m = 0; m < 4; ++m) { bf16_t* rowp = H + (size_t)((u.pm - pm0) * BM + wr * 64 + ai * HALF + m * 16 + fr) * ldh + col0;
                const f32x4 g0 = acc[ai][0][m][0] * sc, g1 = acc[ai][0][m][1] * sc, u0 = acc[ai][1][m][0] * sc, u1 = acc[ai][1][m][1] * sc;
                f32x4 h0, h1;
#pragma unroll
                for (int j = 0; j < 4; ++j) { h0[j] = silu_f(g0[j]) * u0[j]; h1[j] = silu_f(g1[j]) * u1[j]; }
                if constexpr (OUT8) { unsigned char* rp8 = (unsigned char*)H + (size_t)((u.pm - pm0) * BM + wr * 64 + ai * HALF + m * 16 + fr) * ldh + col0;
                    int w0 = __builtin_amdgcn_cvt_pk_fp8_f32(h0[0] * osc, h0[1] * osc, 0, false); w0 = __builtin_amdgcn_cvt_pk_fp8_f32(h0[2] * osc, h0[3] * osc, w0, true);
                    int w1 = __builtin_amdgcn_cvt_pk_fp8_f32(h1[0] * osc, h1[1] * osc, 0, false); w1 = __builtin_amdgcn_cvt_pk_fp8_f32(h1[2] * osc, h1[3] * osc, w1, true);
                    *(unsigned long long*)rp8 = (unsigned long long)(unsigned)w0 | ((unsigned long long)(unsigned)w1 << 32); }
                else { u32x4 w; w.x = cvt_pk_bf16(h0[0], h0[1]); w.y = cvt_pk_bf16(h0[2], h0[3]); w.z = cvt_pk_bf16(h1[0], h1[1]); w.w = cvt_pk_bf16(h1[2], h1[3]);
                    *(u32x4*)rowp = w; } }
    }
};
typedef EpiSwiGLUT<false> EpiSwiGLU;
struct EpiGelu {
    static constexpr bool PERM = true;
    bf16_t* O; int ldc;
    __device__ __forceinline__ void operator()(const f32x4 (&acc)[2][2][4][2], const Unit& u, int wr, int wc, int fr, int fq) const {
        const int col0 = u.pn * BM + wc * 32 + 8 * fq;
#pragma unroll
        for (int ai = 0; ai < 2; ++ai)
#pragma unroll
            for (int m = 0; m < 4; ++m) { bf16_t* rowp = O + (size_t)(u.pm * BM + wr * 64 + ai * HALF + m * 16 + fr) * ldc + col0;
#pragma unroll
                for (int bj = 0; bj < 2; ++bj) { const f32x4 v0 = acc[ai][bj][m][0], v1 = acc[ai][bj][m][1];
                    const f32x2 a = gelu_pk((f32x2){v0[0], v0[1]}), b = gelu_pk((f32x2){v0[2], v0[3]}), c = gelu_pk((f32x2){v1[0], v1[1]}), d = gelu_pk((f32x2){v1[2], v1[3]});
                    u32x4 w; w.x = cvt_pk_bf16(a.x, a.y); w.y = cvt_pk_bf16(b.x, b.y); w.z = cvt_pk_bf16(c.x, c.y); w.w = cvt_pk_bf16(d.x, d.y);
                    *(u32x4*)(rowp + bj * HALF) = w; } }
    }
};
struct EpiStore {
    static constexpr bool PERM = true;
    bf16_t* O; int ldc, pm0; float sc;
    __device__ __forceinline__ void operator()(const f32x4 (&acc)[2][2][4][2], const Unit& u, int wr, int wc, int fr, int fq) const {
        const int col0 = u.pn * BM + wc * 32 + 8 * fq;
#pragma unroll
        for (int ai = 0; ai < 2; ++ai)
#pragma unroll
            for (int m = 0; m < 4; ++m) { bf16_t* rowp = O + (size_t)((u.pm + pm0) * BM + wr * 64 + ai * HALF + m * 16 + fr) * ldc + col0;
#pragma unroll
                for (int bj = 0; bj < 2; ++bj) { const f32x4 v0 = acc[ai][bj][m][0] * sc, v1 = acc[ai][bj][m][1] * sc;
                    u32x4 w; w.x = cvt_pk_bf16(v0[0], v0[1]); w.y = cvt_pk_bf16(v0[2], v0[3]); w.z = cvt_pk_bf16(v1[0], v1[1]); w.w = cvt_pk_bf16(v1[2], v1[3]);
                    *(u32x4*)(rowp + bj * HALF) = w; } }
    }
};

typedef int v8i32 __attribute__((ext_vector_type(8)));
typedef int v4i32 __attribute__((ext_vector_type(4)));
typedef int v6i32 __attribute__((ext_vector_type(6)));
typedef float v16f32 __attribute__((ext_vector_type(16)));
__device__ __forceinline__ v6i32 lo6(v8i32 x) { return __builtin_shufflevector(x, x, 0, 1, 2, 3, 4, 5); }
__device__ __forceinline__ v8i32 fp6_chunk(v16f32 x, v16f32 y, float mx) {
    int e = __builtin_amdgcn_frexp_expf(mx * 1.0666667f) - 3;
    e = e < -100 ? -100 : e;
    const float inv = __int_as_float((127 - e) << 23);
    const v6i32 q = __builtin_amdgcn_cvt_scalef32_2xpk16_fp6_f32(x * inv, y * inv, 1.0f);
    const int sw = ((e + 127) & 0xff) * 0x01010101;
    return (v8i32){q[0], q[1], q[2], q[3], q[4], q[5], sw, 0};
}
__device__ __forceinline__ v8i32 cat32(bf16x8 a, bf16x8 b) { const v4i32 x = __builtin_bit_cast(v4i32, a), y = __builtin_bit_cast(v4i32, b); return __builtin_shufflevector(x, y, 0, 1, 2, 3, 4, 5, 6, 7); }
template <class Epi, class Sched, int F8 = 0  >
__device__ __forceinline__ void gemm_phase(PG8_LAS unsigned char* lds, const Gemm g, const Sched& S, const Epi& E) {
    const int tid = threadIdx.x, wid = __builtin_amdgcn_readfirstlane(tid >> 6), lane = tid & 63, wr = wid >> 2, wc = wid & 3, fr = lane & 15, fq = lane >> 4;
    const int K = g.K, nt = K / BK;
    unsigned voffA[2], voffB[2];
#pragma unroll
    for (int i = 0; i < 2; ++i) { int R, C; stage_rc(tid * 16 + i * 8192, R, C); const int Rb = Epi::PERM ? ((R & ~31) + perm32(R & 31)) : R;
        voffA[i] = (unsigned)(R * g.lda + C) * 2u; voffB[i] = (unsigned)(Rb * g.ldb + C) * 2u; }
    const size_t kstep = (size_t)(BK * 2);
    const size_t hstepA = (size_t)HALF * g.lda * 2, hstepB = (size_t)HALF * g.ldb * 2;
    const size_t tstepA = 2 * hstepA, tstepB = 2 * hstepB;
    const unsigned ldsw = (unsigned)wid * 1024u;
    const int aoff = lds_byte(wr * 64 + fr, fq * 8), boff = lds_byte(wc * 32 + fr, fq * 8);
#define PG8_SA(b, h) (((b) * 2 + (h)) * HTB)
#define PG8_SB(b, h) ((4 + (b) * 2 + (h)) * HTB)
#define PG8_STAGE(bufoff, gbase, voff) do { _Pragma("unroll") for (int _i = 0; _i < 2; ++_i) \
        __builtin_amdgcn_global_load_lds((const unsigned*)((const char*)(gbase) + (voff)[_i]), (PG8_LAS unsigned*)(lds + (bufoff) + ldsw + _i * 8192), 16, 0, 0); } while (0)
#define PG8_LD16(off) (*(const PG8_LAS bf16x8*)(lds + (off)))
#define PG8_LDA(dst, b, h) do { if constexpr (F8 != 0) { _Pragma("unroll") for (int m = 0; m < 4; ++m) dst##8[m] = cat32(PG8_LD16(PG8_SA(b, h) + aoff + m * 2048), PG8_LD16(PG8_SA(b, h) + aoff + m * 2048 + 1024)); } \
      else { _Pragma("unroll") for (int m = 0; m < 4; ++m) _Pragma("unroll") for (int k = 0; k < 2; ++k) dst[m][k] = PG8_LD16(PG8_SA(b, h) + aoff + m * 2048 + k * 1024); } } while (0)
#define PG8_LDB(dst, b, h) do { if constexpr (F8 != 0) { _Pragma("unroll") for (int n = 0; n < 2; ++n) dst##8[n] = cat32(PG8_LD16(PG8_SB(b, h) + boff + n * 2048), PG8_LD16(PG8_SB(b, h) + boff + n * 2048 + 1024)); } \
      else { _Pragma("unroll") for (int n = 0; n < 2; ++n) _Pragma("unroll") for (int k = 0; k < 2; ++k) dst[n][k] = PG8_LD16(PG8_SB(b, h) + boff + n * 2048 + k * 1024); } } while (0)
#define PG8_MMA(ai, bj, At, Bt) do { __builtin_amdgcn_s_setprio(1); if constexpr (F8 == 2) { \
        _Pragma("unroll") for (int m = 0; m < 4; ++m) asm volatile("" : "+v"(At##8[m])); _Pragma("unroll") for (int n = 0; n < 2; ++n) asm volatile("" : "+v"(Bt##8[n]));   \
        _Pragma("unroll") for (int m = 0; m < 4; ++m) _Pragma("unroll") for (int n = 0; n < 2; ++n) \
        asm volatile("v_mfma_scale_f32_16x16x128_f8f6f4 %0, %1, %2, %0, %3, %4 op_sel_hi:[0,0,0] cbsz:2 blgp:2" : "+v"(acc[ai][bj][m][n]) : "v"(lo6(Bt##8[n])), "v"(lo6(At##8[m])), "v"(Bt##8[n][6]), "v"(At##8[m][6])); } \
      else if constexpr (F8 == 1) { _Pragma("unroll") for (int m = 0; m < 4; ++m) _Pragma("unroll") for (int n = 0; n < 2; ++n) \
        asm volatile("v_mfma_scale_f32_16x16x128_f8f6f4 %0, %1, %2, %0, %3, %3 op_sel_hi:[0,0,0]" : "+v"(acc[ai][bj][m][n]) : "v"(Bt##8[n]), "v"(At##8[m]), "v"(sc8)); } \
      else { _Pragma("unroll") for (int m = 0; m < 4; ++m) _Pragma("unroll") for (int n = 0; n < 2; ++n) _Pragma("unroll") for (int k = 0; k < 2; ++k) \
        acc[ai][bj][m][n] = __builtin_amdgcn_mfma_f32_16x16x32_bf16(Bt[n][k], At[m][k], acc[ai][bj][m][n], 0, 0, 0); } __builtin_amdgcn_s_setprio(0); } while (0)
#define PG8_WAIT_V(n) asm volatile("s_waitcnt vmcnt(" #n ")" ::: "memory")
#define PG8_WAIT_L(n) asm volatile("s_waitcnt lgkmcnt(" #n ")" ::: "memory")
#define PG8_BAR __builtin_amdgcn_s_barrier()
#define PG8_SCHED __builtin_amdgcn_sched_barrier(0)
    Unit cur, nxt; int ui = 0;
    if (!S.next(0, cur)) return;
    f32x4 acc[2][2][4][2];
#pragma unroll
    for (int a = 0; a < 2; ++a)
#pragma unroll
        for (int b = 0; b < 2; ++b)
#pragma unroll
            for (int m = 0; m < 4; ++m)
#pragma unroll
                for (int n = 0; n < 2; ++n) acc[a][b][m][n] = (f32x4){0.f, 0.f, 0.f, 0.f};
    const int sc8 = 0x7f7f7f7f;
    bf16x8 At[4][2], B0[2][2], B1[2][2]; v8i32 At8[4], B08[2], B18[2];
    const char* cA = (const char*)g.A + (size_t)cur.pm * tstepA; const char* cB = (const char*)g.Bt + (size_t)cur.pb * tstepB;
    PG8_STAGE(PG8_SB(0, 0), cB, voffB); PG8_STAGE(PG8_SB(0, 1), cB + hstepB, voffB); PG8_STAGE(PG8_SA(0, 0), cA, voffA); PG8_STAGE(PG8_SA(0, 1), cA + hstepA, voffA);
    if (wr == 1) PG8_BAR;
    PG8_WAIT_V(2); PG8_BAR;
    PG8_STAGE(PG8_SB(1, 0), cB + kstep, voffB); PG8_STAGE(PG8_SA(1, 0), cA + kstep, voffA); PG8_STAGE(PG8_SB(1, 1), cB + hstepB + kstep, voffB);
    PG8_WAIT_V(6); PG8_BAR;
    for (;;) {
        const bool has_next = S.next(ui + 1, nxt);
        const char* nA = has_next ? (const char*)g.A + (size_t)nxt.pm * tstepA : cA; const char* nB = has_next ? (const char*)g.Bt + (size_t)nxt.pb * tstepB : cB;
        for (int t = 0; t < nt; t += 2) {
            const bool last = (t == nt - 2);
            const char* a1 = cA + (size_t)(t + 1) * kstep;
            const char* a2 = last ? nA : cA + (size_t)(t + 2) * kstep; const char* b2 = last ? nB : cB + (size_t)(t + 2) * kstep;
            const char* a3 = a2 + kstep; const char* b3 = b2 + kstep;
            PG8_LDB(B0, 0, 0); PG8_LDB(B1, 0, 1); PG8_SCHED; PG8_LDA(At, 0, 0); PG8_STAGE(PG8_SA(1, 1), a1 + hstepA, voffA);
            PG8_WAIT_V(8); PG8_WAIT_L(0); PG8_BAR; PG8_MMA(0, 0, At, B0); PG8_MMA(0, 1, At, B1); PG8_BAR; PG8_SCHED;
            PG8_LDA(At, 0, 1); PG8_STAGE(PG8_SB(0, 0), b2, voffB); PG8_STAGE(PG8_SB(0, 1), b2 + hstepB, voffB); PG8_STAGE(PG8_SA(0, 0), a2, voffA);
            PG8_WAIT_V(8); PG8_WAIT_L(0); PG8_BAR; PG8_MMA(1, 0, At, B0); PG8_MMA(1, 1, At, B1); PG8_BAR; PG8_SCHED;
            PG8_LDB(B0, 1, 0); PG8_LDB(B1, 1, 1); PG8_SCHED; PG8_LDA(At, 1, 0); PG8_STAGE(PG8_SA(0, 1), a2 + hstepA, voffA);
            PG8_WAIT_V(8); PG8_WAIT_L(0); PG8_BAR; PG8_MMA(0, 0, At, B0); PG8_MMA(0, 1, At, B1); PG8_BAR; PG8_SCHED;
            PG8_LDA(At, 1, 1); PG8_STAGE(PG8_SB(1, 0), b3, voffB); PG8_STAGE(PG8_SB(1, 1), b3 + hstepB, voffB); PG8_STAGE(PG8_SA(1, 0), a3, voffA);
            PG8_WAIT_V(8); PG8_WAIT_L(0); PG8_BAR; PG8_MMA(1, 0, At, B0); PG8_MMA(1, 1, At, B1); PG8_BAR; PG8_SCHED;
        }
        if (wr == 0) PG8_BAR;
        if constexpr (F8 != 0) asm volatile("s_nop 15\n\ts_nop 15" ::: "memory");
        { int fr_ = fr, fq_ = fq; asm volatile("" : "+v"(fr_), "+v"(fq_));
          E(acc, cur, wr, wc, fr_, fq_); }
        if (!has_next) break;
#pragma unroll
        for (int a = 0; a < 2; ++a)
#pragma unroll
            for (int b = 0; b < 2; ++b)
#pragma unroll
                for (int m = 0; m < 4; ++m)
#pragma unroll
                    for (int n = 0; n < 2; ++n) acc[a][b][m][n] = (f32x4){0.f, 0.f, 0.f, 0.f};
        cur = nxt; cA = nA; cB = nB; ++ui;
        if (wr == 1) PG8_BAR;
    }
    PG8_WAIT_V(0);
    PG8_BAR;
#undef PG8_SA
#undef PG8_SB
#undef PG8_STAGE
#undef PG8_LDA
#undef PG8_LD16
#undef PG8_LDB
#undef PG8_MMA
#undef PG8_WAIT_V
#undef PG8_WAIT_L
#undef PG8_BAR
#undef PG8_SCHED
}
}

namespace att {
using bf16x8 = __attribute__((ext_vector_type(8))) short;
using s16x4  = __attribute__((ext_vector_type(4))) short;
using f32x16 = __attribute__((ext_vector_type(16))) float;
using u32x4  = __attribute__((ext_vector_type(4))) unsigned;
typedef unsigned short bf16_t;
constexpr int NW = 8, QBLK = 32, KVBLK = 64, NT = SK / KVBLK;
constexpr int KCS = 1040;
constexpr int SHM_V = KVBLK * 128 * 2, SHM_K = 8 * KCS;
constexpr int LDS_BYTES = 3 * 8192 + 3 * 16384 + NW * 256;
constexpr float SUM_THR = 8192.f;
constexpr float L_THR = 1.0995116e12f;
constexpr float SUM_THR8 = 256.f;
constexpr float THR2 = 8.f;
#define SBAR() __builtin_amdgcn_sched_barrier(0)
__device__ __forceinline__ int crow(int r, int hi) { return (r & 3) + 8 * (r >> 2) + 4 * hi; }
__device__ __forceinline__ unsigned cvtpk(float lo, float hi) { unsigned r; asm volatile("v_cvt_pk_bf16_f32 %0, %1, %2" : "=v"(r) : "v"(lo), "v"(hi)); return r; }
typedef float f32x2_t __attribute__((ext_vector_type(2))); typedef __bf16 bf16x2_t __attribute__((ext_vector_type(2)));
__device__ __forceinline__ unsigned cvtpk_s(float lo, float hi) { f32x2_t v = {lo, hi}; bf16x2_t b = __builtin_convertvector(v, bf16x2_t); return __builtin_bit_cast(unsigned, b); }
__device__ __forceinline__ float fadd_s(float a, float b) { float r; asm("v_add_f32_e32 %0, %1, %2" : "=v"(r) : "v"(a), "v"(b)); return r; }
__device__ __forceinline__ float bf_lo(unsigned w) { return __uint_as_float(w << 16); }
__device__ __forceinline__ float bf_hi(unsigned w) { return __uint_as_float(w & 0xffff0000u); }

__device__ __forceinline__ void partialSM(f32x16& p0, f32x16& p1, float& m_reg, float& alpha) {
  float pmax = p0[0];
#pragma unroll
  for (int r = 1; r < 16; ++r) pmax = fmaxf(pmax, p0[r]);
#pragma unroll
  for (int r = 0; r < 16; ++r) pmax = fmaxf(pmax, p1[r]);
  { auto rr = __builtin_amdgcn_permlane32_swap(__float_as_uint(pmax), __float_as_uint(pmax), false, false);
    pmax = fmaxf(__uint_as_float(rr[0]), __uint_as_float(rr[1])); }
  float mn;
  if (__builtin_expect(__all(pmax - m_reg <= THR2), 1)) { mn = m_reg; alpha = 1.f; }
  else { mn = fmaxf(m_reg, pmax); alpha = __builtin_amdgcn_exp2f(m_reg - mn); m_reg = mn; }
#pragma unroll
  for (int r = 0; r < 16; ++r) p0[r] -= mn;
#pragma unroll
  for (int r = 0; r < 16; ++r) p1[r] -= mn;
#pragma unroll
  for (int r = 0; r < 16; ++r) p0[r] = __builtin_amdgcn_exp2f(p0[r]);
}
__device__ __forceinline__ void finishSM(f32x16& p0, f32x16& p1, float alpha, float& l_reg, bf16x8& pa0, bf16x8& pa1, bf16x8& pa2, bf16x8& pa3) {
#pragma unroll
  for (int r = 0; r < 16; ++r) p1[r] = __builtin_amdgcn_exp2f(p1[r]);
  float ps = 0;
#pragma unroll
  for (int r = 0; r < 16; ++r) ps += p0[r];
#pragma unroll
  for (int r = 0; r < 16; ++r) ps += p1[r];
  { auto rr = __builtin_amdgcn_permlane32_swap(__float_as_uint(ps), __float_as_uint(ps), false, false);
    ps = __uint_as_float(rr[0]) + __uint_as_float(rr[1]); }
  l_reg = l_reg * alpha + ps;
#define PK4(P, BASE, OUT) do { unsigned a0 = cvtpk(P[BASE + 0], P[BASE + 1]), a1 = cvtpk(P[BASE + 2], P[BASE + 3]);   \
    unsigned b0 = cvtpk(P[BASE + 4], P[BASE + 5]), b1 = cvtpk(P[BASE + 6], P[BASE + 7]);                              \
    auto r0 = __builtin_amdgcn_permlane32_swap(a0, b0, false, false); auto r1 = __builtin_amdgcn_permlane32_swap(a1, b1, false, false); \
    u32x4 w = {r0[0], r1[0], r0[1], r1[1]}; OUT = *reinterpret_cast<bf16x8*>(&w); } while (0)
  PK4(p0, 0, pa0); PK4(p0, 8, pa1); PK4(p1, 0, pa2); PK4(p1, 8, pa3);
#undef PK4
}
__device__ __forceinline__ void qkt(f32x16& p0, f32x16& p1, const char* Ks, const bf16x8* qr, int r32, int hi) {
  p0 = f32x16{}; p1 = f32x16{};
#pragma unroll
  for (int d0 = 0; d0 < 4; ++d0) {
    const bf16x8 b0 = *reinterpret_cast<const bf16x8*>(Ks + (2 * d0 + hi) * KCS + r32 * 16);
    const bf16x8 b1 = *reinterpret_cast<const bf16x8*>(Ks + (2 * d0 + hi) * KCS + 512 + r32 * 16);
    p0 = __builtin_amdgcn_mfma_f32_32x32x16_bf16(b0, qr[d0], p0, 0, 0, 0);
    p1 = __builtin_amdgcn_mfma_f32_32x32x16_bf16(b1, qr[d0], p1, 0, 0, 0); }
}
__device__ __forceinline__ int v_st(int k, int c) { const int kk = (k & ~0xC) | ((k & 4) << 1) | ((k & 8) >> 1); return ((kk >> 3) * 4 + (c >> 5)) * 512 + ((kk & 7) * 32 + (c & 31)) * 2; }
__device__ __forceinline__ int v_rd_base(int lane) { return ((lane & 3) << 3) | (((lane >> 2) & 3) << 6) | (((lane >> 4) & 1) << 5) | (((lane >> 5) & 1) << 8); }
constexpr int v_rd_off(int d0, int ks, int half) { return d0 * 512 + ks * 4096 + half * 2048; }
template <int OFF> __device__ __forceinline__ s16x4 tr_read(int vb) {
  s16x4 r; asm volatile("ds_read_b64_tr_b16 %0, %1 offset:%2" : "=&v"(r) : "v"(vb), "i"(OFF) : "memory"); return r;
}
template <int D0> __device__ __forceinline__ void pv_one(f32x16& od, int vb, bf16x8 pa0, bf16x8 pa1, bf16x8 pa2, bf16x8 pa3) {
  const s16x4 l0 = tr_read<v_rd_off(D0, 0, 0)>(vb), h0 = tr_read<v_rd_off(D0, 0, 1)>(vb), l1 = tr_read<v_rd_off(D0, 1, 0)>(vb), h1 = tr_read<v_rd_off(D0, 1, 1)>(vb);
  const s16x4 l2 = tr_read<v_rd_off(D0, 2, 0)>(vb), h2 = tr_read<v_rd_off(D0, 2, 1)>(vb), l3 = tr_read<v_rd_off(D0, 3, 0)>(vb), h3 = tr_read<v_rd_off(D0, 3, 1)>(vb);
  asm volatile("s_waitcnt lgkmcnt(0)" ::: "memory"); SBAR();
#define PK(L, H) (bf16x8){L[0], L[1], L[2], L[3], H[0], H[1], H[2], H[3]}
  od = __builtin_amdgcn_mfma_f32_32x32x16_bf16(pa0, PK(l0, h0), od, 0, 0, 0);
  od = __builtin_amdgcn_mfma_f32_32x32x16_bf16(pa1, PK(l1, h1), od, 0, 0, 0);
  od = __builtin_amdgcn_mfma_f32_32x32x16_bf16(pa2, PK(l2, h2), od, 0, 0, 0);
  od = __builtin_amdgcn_mfma_f32_32x32x16_bf16(pa3, PK(l3, h3), od, 0, 0, 0);
#undef PK
}
__device__ __forceinline__ void pv_d0(f32x16* o, int vb, bf16x8 pa0, bf16x8 pa1, bf16x8 pa2, bf16x8 pa3) {
  pv_one<0>(o[0], vb, pa0, pa1, pa2, pa3); pv_one<1>(o[1], vb, pa0, pa1, pa2, pa3); pv_one<2>(o[2], vb, pa0, pa1, pa2, pa3); pv_one<3>(o[3], vb, pa0, pa1, pa2, pa3);
}

constexpr int NSLOT = 3, KSLOT = 8192, VSLOT = 16384;
constexpr int R_K = 0, R_V = NSLOT * KSLOT, R_WS = R_V + NSLOT * VSLOT, RING_LDS = R_WS + NW * 256;
typedef __attribute__((address_space(3))) const char* lds_cptr;
typedef short v4i16_t __attribute__((ext_vector_type(4)));
__device__ __forceinline__ void glds16(const void* gsrc, unsigned lds_dst) { unsigned keep;
  asm volatile("s_mov_b32 %0, m0\n\ts_mov_b32 m0, %2\n\ts_nop 0\n\tglobal_load_lds_dwordx4 %1, off\n\ts_mov_b32 m0, %0" : "=&s"(keep) : "v"(gsrc), "s"(lds_dst) : "memory"); }
__device__ __forceinline__ s16x4 vtr(lds_cptr p) { return __builtin_bit_cast(s16x4, __builtin_amdgcn_ds_read_tr16_b64_v4i16((__attribute__((address_space(3))) v4i16_t*)p)); }
#define BAR_ONLY() asm volatile("s_barrier" ::: "memory")
#define WAIT_BAR() asm volatile("s_waitcnt vmcnt(0) lgkmcnt(0)\n\ts_barrier" ::: "memory")
#define LGKM_BAR() asm volatile("s_waitcnt lgkmcnt(0)\n\ts_barrier" ::: "memory")

template <bool FIRST>
__device__ __forceinline__ void softmax_seg(f32x16& p0, f32x16& p1, float& mhat, f32x16& negm, float& l_reg, f32x16 (&o)[4], float* wsf, int r32, int hi,
                                            bf16x8& pa0, bf16x8& pa1, bf16x8& pa2, bf16x8& pa3) {
  if (FIRST) {
    float a = fmaxf(fmaxf(p0[0], p0[1]), p1[0]), b = fmaxf(fmaxf(p0[2], p0[3]), p1[1]); a = fmaxf(fmaxf(a, p1[2]), p1[3]);
#pragma unroll
    for (int r = 4; r < 16; r += 4) { a = fmaxf(fmaxf(a, p0[r]), p0[r + 1]); b = fmaxf(fmaxf(b, p0[r + 2]), p0[r + 3]); a = fmaxf(fmaxf(a, p1[r]), p1[r + 1]); b = fmaxf(fmaxf(b, p1[r + 2]), p1[r + 3]); }
    float rm = fmaxf(a, b);
    { auto rr = __builtin_amdgcn_permlane32_swap(__float_as_uint(rm), __float_as_uint(rm), false, false); rm = fmaxf(__uint_as_float(rr[0]), __uint_as_float(rr[1])); }
    mhat += rm;
#pragma unroll
    for (int r = 0; r < 16; ++r) { p0[r] -= rm; p1[r] -= rm; }
#pragma unroll
    for (int r = 0; r < 16; ++r) negm[r] = -mhat;
    asm volatile("" : "+v"(negm));
  }
#pragma unroll
  for (int r = 0; r < 16; ++r) p0[r] = __builtin_amdgcn_exp2f(p0[r]);
#pragma unroll
  for (int r = 0; r < 16; ++r) p1[r] = __builtin_amdgcn_exp2f(p1[r]);
  float s0 = p0[0] + p0[1], s1 = p1[0] + p1[1];
#pragma unroll
  for (int r = 2; r < 16; ++r) { s0 += p0[r]; asm volatile("" : "+v"(s0)); s1 += p1[r]; asm volatile("" : "+v"(s1)); }
  float st = s0 + s1;
  if (!FIRST && __builtin_expect(__any(st > SUM_THR), 0)) {
    float a = fmaxf(fmaxf(p0[0], p0[1]), p1[0]), b = fmaxf(fmaxf(p0[2], p0[3]), p1[1]); a = fmaxf(fmaxf(a, p1[2]), p1[3]);
#pragma unroll
    for (int r = 4; r < 16; r += 4) { a = fmaxf(fmaxf(a, p0[r]), p0[r + 1]); b = fmaxf(fmaxf(b, p0[r + 2]), p0[r + 3]); a = fmaxf(fmaxf(a, p1[r]), p1[r + 1]); b = fmaxf(fmaxf(b, p1[r + 2]), p1[r + 3]); }
    float rm = fmaxf(a, b);
    { auto rr = __builtin_amdgcn_permlane32_swap(__float_as_uint(rm), __float_as_uint(rm), false, false); rm = fmaxf(__uint_as_float(rr[0]), __uint_as_float(rr[1])); }
    const float dl = fmaxf(ceilf(__builtin_amdgcn_logf(rm)), 0.f), f = __builtin_amdgcn_exp2f(-dl);
    mhat += dl; l_reg *= f; st *= f;
#pragma unroll
    for (int r = 0; r < 16; ++r) { p0[r] *= f; p1[r] *= f; }
#pragma unroll
    for (int r = 0; r < 16; ++r) negm[r] = -mhat;
    asm volatile("" : "+v"(negm));
    if (hi == 0) wsf[r32] = f; asm volatile("s_waitcnt lgkmcnt(0)" ::: "memory");
#pragma unroll
    for (int r = 0; r < 16; ++r) { const float fr = wsf[crow(r, hi)];
#pragma unroll
      for (int d = 0; d < 4; ++d) o[d][r] *= fr; }
  }
  l_reg += st;
#define PK8(P, BASE, OUT) do { u32x4 w = {cvtpk_s(P[BASE + 0], P[BASE + 1]), cvtpk_s(P[BASE + 2], P[BASE + 3]), cvtpk_s(P[BASE + 4], P[BASE + 5]), cvtpk_s(P[BASE + 6], P[BASE + 7])}; OUT = *reinterpret_cast<bf16x8*>(&w); } while (0)
  PK8(p0, 0, pa0); PK8(p0, 8, pa1); PK8(p1, 0, pa2); PK8(p1, 8, pa3);
#undef PK8
}

__device__ __forceinline__ void flash_pass(const bf16_t* __restrict__ Qrow, const bf16_t* __restrict__ Kh, const bf16_t* __restrict__ Vh, char* lds, f32x16 (&o)[4], float& l_out) {
  int tid = threadIdx.x; asm volatile("" : "+v"(tid));
  const int lane = tid & 63, r32 = lane & 31, hi = lane >> 5; const int wid = __builtin_amdgcn_readfirstlane(tid >> 6), half = wid >> 2;
  const unsigned lds0 = (unsigned)(uintptr_t)lds;
  float* wsf = (float*)(lds + R_WS) + wid * 64;
  const bf16_t* ksrc = Kh + (long)(16 * (wid >> 1) + (lane >> 2)) * DM + (wid & 1) * 32 + (((lane & 3) ^ ((lane >> 4) & 3))) * 8;
  const bf16_t* vsrc = Vh + (long)(16 * (wid & 3) + (lane >> 2)) * DM + (wid >> 2) * 32 + (lane & 3) * 8;
  const unsigned kdst = lds0 + R_K + wid * 1024, vdst = lds0 + R_V + wid * 1024;
#define DMA_K(t, slot) glds16(ksrc + (long)(t) * KVBLK * DM, (unsigned)__builtin_amdgcn_readfirstlane(kdst + (slot)))
#define DMA_V(t, slot) do { glds16(vsrc + (long)(t) * KVBLK * DM, (unsigned)__builtin_amdgcn_readfirstlane(vdst + (slot))); glds16(vsrc + (long)(t) * KVBLK * DM + 64, (unsigned)__builtin_amdgcn_readfirstlane(vdst + (slot) + 8192)); } while (0)
  const lds_cptr shm3 = (lds_cptr)lds;
  const lds_cptr kpl = shm3 + R_K + (r32 >> 4) * 2048 + (r32 & 15) * 64;
  const lds_cptr kpe = kpl + ((hi ^ ((r32 >> 2) & 3)) * 16), kpo = kpl + (((2 + hi) ^ ((r32 >> 2) & 3)) * 16);
  const lds_cptr vp0 = shm3 + R_V + ((lane >> 4) & 1) * 32 + (lane & 3) * 8 + (4 * hi + ((lane & 15) >> 2)) * 64;
  DMA_K(0, 0); DMA_K(1, KSLOT); DMA_V(0, 0); DMA_K(2, 2 * KSLOT); DMA_V(1, VSLOT);
  bf16x8 qr[4];
#pragma unroll
  for (int d0 = 0; d0 < 4; ++d0) qr[d0] = *reinterpret_cast<const bf16x8*>(Qrow + d0 * 16);
#pragma unroll
  for (int d = 0; d < 4; ++d) o[d] = f32x16{};
  float mhat = 0.f, l_reg = 0.f; f32x16 negm;
  { float z; asm volatile("v_mov_b32 %0, 0" : "=v"(z));
#pragma unroll
    for (int r = 0; r < 16; ++r) negm[r] = z; }
  f32x16 p0, p1; bf16x8 pa0, pa1, pa2, pa3;
#define KLD(slot) do { _Pragma("unroll") for (int d0 = 0; d0 < 4; ++d0) { const lds_cptr kq_ = ((d0 & 1) ? kpo : kpe) + (slot) + (d0 >> 1) * 1024; kf[2 * d0] = *(const __attribute__((address_space(3))) bf16x8*)(kq_); kf[2 * d0 + 1] = *(const __attribute__((address_space(3))) bf16x8*)(kq_ + 4096); } } while (0)
#define QKM() do { p0 = __builtin_amdgcn_mfma_f32_32x32x16_bf16(kf[0], qr[0], negm, 0, 0, 0); p1 = __builtin_amdgcn_mfma_f32_32x32x16_bf16(kf[1], qr[0], negm, 0, 0, 0); \
    _Pragma("unroll") for (int d0 = 1; d0 < 4; ++d0) { p0 = __builtin_amdgcn_mfma_f32_32x32x16_bf16(kf[2 * d0], qr[d0], p0, 0, 0, 0); p1 = __builtin_amdgcn_mfma_f32_32x32x16_bf16(kf[2 * d0 + 1], qr[d0], p1, 0, 0, 0); } } while (0)
#define QKT(kp) do { KLD(kp); QKM(); } while (0)
#define VLD(L, H, vp, D0) do { _Pragma("unroll") for (int ks = 0; ks < 4; ++ks) { L[ks] = vtr((vp) + ((D0) >> 1) * 8192 + ((D0) & 1) * 4096 + ks * 1024); H[ks] = vtr((vp) + ((D0) >> 1) * 8192 + ((D0) & 1) * 4096 + ks * 1024 + 512); } } while (0)
#define VFRG(L, H, k) ((bf16x8){L[k][0], L[k][1], L[k][2], L[k][3], H[k][0], H[k][1], H[k][2], H[k][3]})
#define PVM(L, H, D0) do { o[D0] = __builtin_amdgcn_mfma_f32_32x32x16_bf16(pa0, VFRG(L, H, 0), o[D0], 0, 0, 0); o[D0] = __builtin_amdgcn_mfma_f32_32x32x16_bf16(pa1, VFRG(L, H, 1), o[D0], 0, 0, 0); \
    o[D0] = __builtin_amdgcn_mfma_f32_32x32x16_bf16(pa2, VFRG(L, H, 2), o[D0], 0, 0, 0); o[D0] = __builtin_amdgcn_mfma_f32_32x32x16_bf16(pa3, VFRG(L, H, 3), o[D0], 0, 0, 0); } while (0)
  bf16x8 kf[8]; s16x4 la[4], ha[4], lb[4], hb[4], lc[4], hc[4];
  WAIT_BAR();
  QKT(0);
  softmax_seg<true>(p0, p1, mhat, negm, l_reg, o, wsf, r32, hi, pa0, pa1, pa2, pa3);
  if (half) BAR_ONLY();
  int ks_next = KSLOT, vs_cur = 0;
#pragma unroll 1
  for (int j = 0; j < NT - 1; ++j) {
    { const lds_cptr vp = vp0 + vs_cur;
      __builtin_amdgcn_s_setprio(3);
      SBAR();
      KLD(ks_next); VLD(la, ha, vp, 0); VLD(lb, hb, vp, 1);
      QKM();
      VLD(lc, hc, vp, 2);
      PVM(la, ha, 0);
      VLD(la, ha, vp, 3);
      PVM(lb, hb, 1); PVM(lc, hc, 2); PVM(la, ha, 3);
      __builtin_amdgcn_sched_group_barrier(0x100, 4, 0);
#pragma unroll
      for (int g_ = 0; g_ < 18; ++g_) { __builtin_amdgcn_sched_group_barrier(0x8, 1, 0); __builtin_amdgcn_sched_group_barrier(0x100, 2, 0); }
#pragma unroll
      for (int g_ = 0; g_ < 6; ++g_) __builtin_amdgcn_sched_group_barrier(0x8, 1, 0);
      SBAR(); }
    __builtin_amdgcn_s_setprio(0);
    WAIT_BAR();
    if (j + 3 < NT) DMA_K(j + 3, (ks_next == KSLOT) ? 0 : ((ks_next == 2 * KSLOT) ? KSLOT : 2 * KSLOT));
    if (j + 2 < NT) DMA_V(j + 2, (vs_cur == 0) ? 2 * VSLOT : vs_cur - VSLOT);
    ks_next = (ks_next == 2 * KSLOT) ? 0 : ks_next + KSLOT; vs_cur = (vs_cur == 2 * VSLOT) ? 0 : vs_cur + VSLOT;
    softmax_seg<false>(p0, p1, mhat, negm, l_reg, o, wsf, r32, hi, pa0, pa1, pa2, pa3);
    LGKM_BAR();
  }
  { const lds_cptr vp = vp0 + vs_cur;
    __builtin_amdgcn_s_setprio(3);
    SBAR(); VLD(la, ha, vp, 0); VLD(lb, hb, vp, 1);
    SBAR(); PVM(la, ha, 0); VLD(la, ha, vp, 2);
    SBAR(); PVM(lb, hb, 1); VLD(lb, hb, vp, 3);
    SBAR(); PVM(la, ha, 2);
    SBAR(); PVM(lb, hb, 3); SBAR(); __builtin_amdgcn_s_setprio(0); WAIT_BAR(); }
  if (!half) BAR_ONLY();
  { auto rr = __builtin_amdgcn_permlane32_swap(__float_as_uint(l_reg), __float_as_uint(l_reg), false, false); l_reg = __uint_as_float(rr[0]) + __uint_as_float(rr[1]); }
  l_out = l_reg;
#undef DMA_K
#undef DMA_V
#undef QKT
#undef KLD
#undef QKM
#undef VLD
#undef VFRG
#undef PVM
}

__device__ __forceinline__ void attn_unit(int b, int h, int qb, const bf16_t* Q, const bf16_t* Kall, const bf16_t* Vall, bf16_t* O, const float* subw, float lam, float* stash, char* lds) {
  const int tid = threadIdx.x, wid = tid >> 6, lane = tid & 63, r32 = lane & 31, hi = lane >> 5;
  const long qrow0 = (long)b * SEQ + qb * 256 + wid * QBLK;
  const bf16_t* Vh = Vall + (long)b * SK * DM + h * 128;
  float* ws = (float*)(lds + R_WS) + wid * 64;
  f32x16 o[4]; float l_reg;
#pragma unroll 1
  for (int c = 0; c < 2; ++c) {
    const bf16_t* Qrow = Q + (qrow0 + r32) * DM + h * 128 + c * 64 + hi * 8;
    const bf16_t* Kh = Kall + (long)b * SK * DM + h * 128 + c * 64;
    flash_pass(Qrow, Kh, Vh, lds, o, l_reg);
    if (hi == 0) ws[r32] = l_reg; asm volatile("s_waitcnt lgkmcnt(0)" ::: "memory");
    {
#pragma unroll
      for (int r = 0; r < 16; ++r) { const float rl = __builtin_amdgcn_rcpf(ws[crow(r, hi)]);
#pragma unroll
        for (int d0 = 0; d0 < 4; ++d0) o[d0][r] *= rl; }
    }
    int tt = tid; asm volatile("" : "+v"(tt));
    float* stl = stash + tt;
    if (c == 0) {
#pragma unroll
      for (int d0 = 0; d0 < 4; ++d0)
#pragma unroll
        for (int r = 0; r < 16; ++r) stl[(d0 * 16 + r) * 512] = o[d0][r];
    } else {
      const int ll = tt & 63, r32l = ll & 31, hil = ll >> 5;
      float ss[16];
#pragma unroll
      for (int r = 0; r < 16; ++r) ss[r] = 0.f;
#pragma unroll
      for (int d0 = 0; d0 < 4; ++d0) {
#pragma unroll
        for (int r = 0; r < 16; ++r) { const float v0 = stl[(d0 * 16 + r) * 512] - lam * o[d0][r]; o[d0][r] = v0; ss[r] += v0 * v0; }
        asm volatile("" ::: "memory"); }
#pragma unroll
      for (int r = 0; r < 16; ++r) { float s = ss[r];
        s += __uint_as_float(__builtin_amdgcn_ds_swizzle(__float_as_uint(s), (1 << 10) | 0x1f)); s += __uint_as_float(__builtin_amdgcn_ds_swizzle(__float_as_uint(s), (2 << 10) | 0x1f));
        s += __uint_as_float(__builtin_amdgcn_ds_swizzle(__float_as_uint(s), (4 << 10) | 0x1f)); s += __uint_as_float(__builtin_amdgcn_ds_swizzle(__float_as_uint(s), (8 << 10) | 0x1f));
        s += __uint_as_float(__builtin_amdgcn_ds_swizzle(__float_as_uint(s), (16 << 10) | 0x1f));
        ss[r] = rsqrtf(s * (1.0f / 128.0f) + EPS) * (1.0f - LAM_INIT); }
      asm volatile("s_waitcnt lgkmcnt(0)" ::: "memory");
      bf16_t* stg = (bf16_t*)(lds + (tt >> 6) * 8192);
      bf16_t* stgl = stg + hil * 4 * 128 + r32l;
#pragma unroll
      for (int d0 = 0; d0 < 4; ++d0) { const float sw = subw[32 * d0 + r32l];
#pragma unroll
        for (int r = 0; r < 16; ++r) { const unsigned w = cvtpk(o[d0][r] * ss[r] * sw, 0.f); stgl[((r & 3) + 8 * (r >> 2)) * 128 + 32 * d0] = (bf16_t)w; } }
      asm volatile("s_waitcnt lgkmcnt(0)" ::: "memory");
      bf16_t* Ow = O + (qrow0 + (ll >> 4)) * DM + h * 128 + (ll & 15) * 8; const bf16_t* srd = stg + (ll >> 4) * 128 + (ll & 15) * 8;
#pragma unroll
      for (int i = 0; i < 8; ++i) { const u32x4 v = *(const u32x4*)(srd + i * 4 * 128); *(u32x4*)(Ow + (long)i * 4 * DM) = v; }
    }
    asm volatile("s_waitcnt vmcnt(0) lgkmcnt(0)\n\ts_barrier" ::: "memory");
  }
}

__device__ __forceinline__ void flash_pass8b(const unsigned char* __restrict__ Q8row, const unsigned char* __restrict__ K8h, const bf16_t* __restrict__ Vh, char* lds, f32x16 (&o)[4], float& l_out) {
  int tid = threadIdx.x; asm volatile("" : "+v"(tid));
  const int lane = tid & 63, r32 = lane & 31, hi = lane >> 5; const int wid = __builtin_amdgcn_readfirstlane(tid >> 6), half = wid >> 2;
  const unsigned lds0 = (unsigned)(uintptr_t)lds;
  float* wsf = (float*)(lds + R_WS) + wid * 64;
  const unsigned char* ksrc = K8h + (wid & 3) * 1024 + lane * 16;
  const bf16_t* vsrc = Vh + (long)(16 * (wid & 3) + (lane >> 2)) * DM + (wid >> 2) * 32 + (lane & 3) * 8;
  const unsigned kdst = lds0 + R_K + (wid & 3) * 1024, vdst = lds0 + R_V + wid * 1024;
#define DMA_K(t, slot) do { if (wid < 4) glds16(ksrc + (long)(t) * 4096, (unsigned)__builtin_amdgcn_readfirstlane(kdst + (slot))); } while (0)
#define DMA_V(t, slot) do { glds16(vsrc + (long)(t) * KVBLK * DM, (unsigned)__builtin_amdgcn_readfirstlane(vdst + (slot))); glds16(vsrc + (long)(t) * KVBLK * DM + 64, (unsigned)__builtin_amdgcn_readfirstlane(vdst + (slot) + 8192)); } while (0)
  const lds_cptr shm3 = (lds_cptr)lds;
  const lds_cptr kq0 = shm3 + R_K + r32 * 64 + (((2 * hi) ^ ((r32 >> 2) & 3)) * 16), kq1 = shm3 + R_K + r32 * 64 + (((2 * hi + 1) ^ ((r32 >> 2) & 3)) * 16);
  const lds_cptr vp0 = shm3 + R_V + ((lane >> 4) & 1) * 32 + (lane & 3) * 8 + (4 * hi + ((lane & 15) >> 2)) * 64;
  DMA_K(0, 0); DMA_K(1, KSLOT); DMA_V(0, 0); DMA_K(2, 2 * KSLOT); DMA_V(1, VSLOT);
  pg8::v8i32 q8 = pg8::cat32(*reinterpret_cast<const bf16x8*>(Q8row), *reinterpret_cast<const bf16x8*>(Q8row + 16));
#pragma unroll
  for (int d = 0; d < 4; ++d) o[d] = f32x16{};
  float mhat = 0.f, l_reg = 0.f; f32x16 negm;
  { float z; asm volatile("v_mov_b32 %0, 0" : "=v"(z));
#pragma unroll
    for (int r = 0; r < 16; ++r) negm[r] = z; }
  int sc8 = 0x7f7f7f7f; asm volatile("" : "+v"(sc8));
  asm volatile("s_waitcnt vmcnt(0)" ::: "memory"); asm volatile("" : "+v"(q8));
  f32x16 p0, p1; bf16x8 pa0, pa1, pa2, pa3;
#define KLD8(slot) do { _Pragma("unroll") for (int blk = 0; blk < 2; ++blk) kf8[blk] = pg8::cat32(*(const __attribute__((address_space(3))) bf16x8*)(kq0 + (slot) + blk * 2048), *(const __attribute__((address_space(3))) bf16x8*)(kq1 + (slot) + blk * 2048)); } while (0)
#define QKM8() do { asm volatile("" : "+v"(kf8[0])); asm volatile("" : "+v"(kf8[1])); \
    asm volatile("v_mfma_scale_f32_32x32x64_f8f6f4 %0, %1, %2, %3, %4, %4 op_sel_hi:[0,0,0]" : "=&v"(p0) : "v"(kf8[0]), "v"(q8), "v"(negm), "v"(sc8)); \
    asm volatile("v_mfma_scale_f32_32x32x64_f8f6f4 %0, %1, %2, %3, %4, %4 op_sel_hi:[0,0,0]" : "=&v"(p1) : "v"(kf8[1]), "v"(q8), "v"(negm), "v"(sc8)); } while (0)
#define VLD(L, H, vp, D0) do { _Pragma("unroll") for (int ks = 0; ks < 4; ++ks) { L[ks] = vtr((vp) + ((D0) >> 1) * 8192 + ((D0) & 1) * 4096 + ks * 1024); H[ks] = vtr((vp) + ((D0) >> 1) * 8192 + ((D0) & 1) * 4096 + ks * 1024 + 512); } } while (0)
#define VFRG(L, H, k) ((bf16x8){L[k][0], L[k][1], L[k][2], L[k][3], H[k][0], H[k][1], H[k][2], H[k][3]})
#define PVM(L, H, D0) do { o[D0] = __builtin_amdgcn_mfma_f32_32x32x16_bf16(pa0, VFRG(L, H, 0), o[D0], 0, 0, 0); o[D0] = __builtin_amdgcn_mfma_f32_32x32x16_bf16(pa1, VFRG(L, H, 1), o[D0], 0, 0, 0); \
    o[D0] = __builtin_amdgcn_mfma_f32_32x32x16_bf16(pa2, VFRG(L, H, 2), o[D0], 0, 0, 0); o[D0] = __builtin_amdgcn_mfma_f32_32x32x16_bf16(pa3, VFRG(L, H, 3), o[D0], 0, 0, 0); } while (0)
  pg8::v8i32 kf8[2]; s16x4 la[4], ha[4], lb[4], hb[4], lc[4], hc[4];
  WAIT_BAR();
  KLD8(0); QKM8();
  asm volatile("s_nop 15\n\ts_nop 15" : "+v"(p0), "+v"(p1), "+v"(negm));
  softmax_seg<true>(p0, p1, mhat, negm, l_reg, o, wsf, r32, hi, pa0, pa1, pa2, pa3);
  if (half) BAR_ONLY();
  int ks_next = KSLOT, vs_cur = 0;
#pragma unroll 1
  for (int j = 0; j < NT - 1; ++j) {
    { const lds_cptr vp = vp0 + vs_cur;
      __builtin_amdgcn_s_setprio(3);
      SBAR();
      KLD8(ks_next); VLD(la, ha, vp, 0); VLD(lb, hb, vp, 1);
      SBAR();
      QKM8();
      SBAR();
      VLD(lc, hc, vp, 2);
      PVM(la, ha, 0);
      VLD(la, ha, vp, 3);
      PVM(lb, hb, 1); PVM(lc, hc, 2); PVM(la, ha, 3);
#pragma unroll
      for (int g_ = 0; g_ < 16; ++g_) { __builtin_amdgcn_sched_group_barrier(0x8, 1, 0); __builtin_amdgcn_sched_group_barrier(0x100, 1, 0); }
      SBAR(); }
    __builtin_amdgcn_s_setprio(0);
    WAIT_BAR();
    if (j + 3 < NT) DMA_K(j + 3, (ks_next == KSLOT) ? 0 : ((ks_next == 2 * KSLOT) ? KSLOT : 2 * KSLOT));
    if (j + 2 < NT) DMA_V(j + 2, (vs_cur == 0) ? 2 * VSLOT : vs_cur - VSLOT);
    ks_next = (ks_next == 2 * KSLOT) ? 0 : ks_next + KSLOT; vs_cur = (vs_cur == 2 * VSLOT) ? 0 : vs_cur + VSLOT;
    softmax_seg<false>(p0, p1, mhat, negm, l_reg, o, wsf, r32, hi, pa0, pa1, pa2, pa3);
    LGKM_BAR();
  }
  { const lds_cptr vp = vp0 + vs_cur;
    __builtin_amdgcn_s_setprio(3);
    SBAR(); VLD(la, ha, vp, 0); VLD(lb, hb, vp, 1);
    SBAR(); PVM(la, ha, 0); VLD(la, ha, vp, 2);
    SBAR(); PVM(lb, hb, 1); VLD(lb, hb, vp, 3);
    SBAR(); PVM(la, ha, 2);
    SBAR(); PVM(lb, hb, 3); SBAR(); __builtin_amdgcn_s_setprio(0); WAIT_BAR(); }
  if (!half) BAR_ONLY();
  { auto rr = __builtin_amdgcn_permlane32_swap(__float_as_uint(l_reg), __float_as_uint(l_reg), false, false); l_reg = __uint_as_float(rr[0]) + __uint_as_float(rr[1]); }
  l_out = l_reg;
#undef DMA_K
#undef DMA_V
#undef KLD8
#undef QKM8
#undef VLD
#undef VFRG
#undef PVM
}

template <bool FIRST>
__device__ __forceinline__ void softmax_seg8(f32x16& p0, f32x16& p1, float& mhat, f32x16& negm, f32x16& lsum, f32x16 (&o)[4], float* wsf, int r32, int hi,
                                            pg8::v8i32& P8) {
  if (FIRST) {
    float a = fmaxf(fmaxf(p0[0], p0[1]), p1[0]), b = fmaxf(fmaxf(p0[2], p0[3]), p1[1]); a = fmaxf(fmaxf(a, p1[2]), p1[3]);
#pragma unroll
    for (int r = 4; r < 16; r += 4) { a = fmaxf(fmaxf(a, p0[r]), p0[r + 1]); b = fmaxf(fmaxf(b, p0[r + 2]), p0[r + 3]); a = fmaxf(fmaxf(a, p1[r]), p1[r + 1]); b = fmaxf(fmaxf(b, p1[r + 2]), p1[r + 3]); }
    float rm = fmaxf(a, b);
    { auto rr = __builtin_amdgcn_permlane32_swap(__float_as_uint(rm), __float_as_uint(rm), false, false); rm = fmaxf(__uint_as_float(rr[0]), __uint_as_float(rr[1])); }
    rm -= 2.0f;
    mhat += rm;
#pragma unroll
    for (int r = 0; r < 16; ++r) { p0[r] -= rm; p1[r] -= rm; }
#pragma unroll
    for (int r = 0; r < 16; ++r) negm[r] = -mhat;
    asm volatile("" : "+v"(negm));
  }
#pragma unroll
  for (int r = 0; r < 16; ++r) p0[r] = __builtin_amdgcn_exp2f(p0[r]);
#pragma unroll
  for (int r = 0; r < 16; ++r) p1[r] = __builtin_amdgcn_exp2f(p1[r]);
  float a = fmaxf(fmaxf(p0[0], p0[1]), p1[0]), b = fmaxf(fmaxf(p0[2], p0[3]), p1[1]); a = fmaxf(fmaxf(a, p1[2]), p1[3]);
#pragma unroll
  for (int r = 4; r < 16; r += 4) { a = fmaxf(fmaxf(a, p0[r]), p0[r + 1]); b = fmaxf(fmaxf(b, p0[r + 2]), p0[r + 3]); a = fmaxf(fmaxf(a, p1[r]), p1[r + 1]); b = fmaxf(fmaxf(b, p1[r + 2]), p1[r + 3]); }
  float rm = fmaxf(a, b);
  if (!FIRST && __builtin_expect(__any(rm > SUM_THR8), 0)) {
    asm volatile("s_nop 15\n\ts_nop 15" : "+v"(o[0]), "+v"(o[1]), "+v"(o[2]), "+v"(o[3]), "+v"(lsum));
    { auto rr = __builtin_amdgcn_permlane32_swap(__float_as_uint(rm), __float_as_uint(rm), false, false); rm = fmaxf(__uint_as_float(rr[0]), __uint_as_float(rr[1])); }
    const float dl = fmaxf(ceilf(__builtin_amdgcn_logf(rm)) - 2.0f, 0.f), f = __builtin_amdgcn_exp2f(-dl);
    mhat += dl;
#pragma unroll
    for (int r = 0; r < 16; ++r) { p0[r] *= f; p1[r] *= f; }
#pragma unroll
    for (int r = 0; r < 16; ++r) negm[r] = -mhat;
    asm volatile("" : "+v"(negm));
    if (hi == 0) wsf[r32] = f; asm volatile("s_waitcnt lgkmcnt(0)" ::: "memory");
#pragma unroll
    for (int r = 0; r < 16; ++r) { const float fr = wsf[crow(r, hi)]; lsum[r] *= fr;
#pragma unroll
      for (int d = 0; d < 4; ++d) o[d][r] *= fr; }
  }
#pragma unroll
  for (int w = 0; w < 4; ++w) { int a2 = __builtin_amdgcn_cvt_pk_fp8_f32(p0[4 * w], p0[4 * w + 1], 0, false); a2 = __builtin_amdgcn_cvt_pk_fp8_f32(p0[4 * w + 2], p0[4 * w + 3], a2, true); P8[w] = a2;
    int c2 = __builtin_amdgcn_cvt_pk_fp8_f32(p1[4 * w], p1[4 * w + 1], 0, false); c2 = __builtin_amdgcn_cvt_pk_fp8_f32(p1[4 * w + 2], p1[4 * w + 3], c2, true); P8[4 + w] = c2; }
}


__device__ __forceinline__ void flash_pass8(const unsigned char* __restrict__ Q8row, const unsigned char* __restrict__ K8h, const unsigned char* __restrict__ V8h, char* lds, f32x16 (&o)[4], f32x16& lsum) {
  int tid = threadIdx.x; asm volatile("" : "+v"(tid));
  const int lane = tid & 63, r32 = lane & 31, hi = lane >> 5; const int wid = __builtin_amdgcn_readfirstlane(tid >> 6), half = wid >> 2;
  const unsigned lds0 = (unsigned)(uintptr_t)lds;
  float* wsf = (float*)(lds + R_WS) + wid * 64;
  const unsigned char* ksrc = K8h + (wid & 3) * 1024 + lane * 16;
  const unsigned char* vsrc = V8h + wid * 1024 + lane * 16;
  const unsigned kdst = lds0 + R_K + (wid & 3) * 1024, vdst = lds0 + R_V + wid * 1024;
#define DMA_K(t, slot) do { if (wid < 4) glds16(ksrc + (long)(t) * 4096, (unsigned)__builtin_amdgcn_readfirstlane(kdst + (slot))); } while (0)
#define DMA_V(t, slot) glds16(vsrc + (long)(t) * 8192, (unsigned)__builtin_amdgcn_readfirstlane(vdst + (slot)))
  const lds_cptr shm3 = (lds_cptr)lds;
  const lds_cptr kq0 = shm3 + R_K + r32 * 64 + (((2 * hi) ^ ((r32 >> 2) & 3)) * 16), kq1 = shm3 + R_K + r32 * 64 + (((2 * hi + 1) ^ ((r32 >> 2) & 3)) * 16);
  const lds_cptr vq0 = shm3 + R_V + r32 * 64 + (((2 * hi) ^ ((r32 >> 2) & 3)) * 16), vq1 = shm3 + R_V + r32 * 64 + (((2 * hi + 1) ^ ((r32 >> 2) & 3)) * 16);
  DMA_K(0, 0); DMA_K(1, KSLOT); DMA_V(0, 0); DMA_K(2, 2 * KSLOT); DMA_V(1, VSLOT);
  pg8::v8i32 q8 = pg8::cat32(*reinterpret_cast<const bf16x8*>(Q8row), *reinterpret_cast<const bf16x8*>(Q8row + 16));
#pragma unroll
  for (int d = 0; d < 4; ++d) o[d] = f32x16{};
  float mhat = 0.f; f32x16 negm; lsum = f32x16{};
  { float z; asm volatile("v_mov_b32 %0, 0" : "=v"(z));
#pragma unroll
    for (int r = 0; r < 16; ++r) negm[r] = z; }
  pg8::v8i32 ones8 = {0x38383838, 0x38383838, 0x38383838, 0x38383838, 0x38383838, 0x38383838, 0x38383838, 0x38383838}; asm volatile("" : "+v"(ones8));
  int sc8 = 0x7f7f7f7f; asm volatile("" : "+v"(sc8));
  asm volatile("s_waitcnt vmcnt(0)" ::: "memory"); asm volatile("" : "+v"(q8));
  f32x16 p0, p1; pg8::v8i32 P8, vf[4], kf8[2];
#define KLD8(slot) do { _Pragma("unroll") for (int blk = 0; blk < 2; ++blk) kf8[blk] = pg8::cat32(*(const __attribute__((address_space(3))) bf16x8*)(kq0 + (slot) + blk * 2048), *(const __attribute__((address_space(3))) bf16x8*)(kq1 + (slot) + blk * 2048)); } while (0)
#define QKM8() do { asm volatile("" : "+v"(kf8[0])); asm volatile("" : "+v"(kf8[1]));   \
    asm volatile("v_mfma_scale_f32_32x32x64_f8f6f4 %0, %1, %2, %3, %4, %5 op_sel_hi:[0,0,0] cbsz:2 blgp:2" : "=&v"(p0) : "v"(pg8::lo6(kf8[0])), "v"(pg8::lo6(q8)), "v"(negm), "v"(kf8[0][6]), "v"(q8[6])); \
    asm volatile("v_mfma_scale_f32_32x32x64_f8f6f4 %0, %1, %2, %3, %4, %5 op_sel_hi:[0,0,0] cbsz:2 blgp:2" : "=&v"(p1) : "v"(pg8::lo6(kf8[1])), "v"(pg8::lo6(q8)), "v"(negm), "v"(kf8[1][6]), "v"(q8[6])); } while (0)
#define V8LD(vs) do { _Pragma("unroll") for (int D0 = 0; D0 < 4; ++D0) vf[D0] = pg8::cat32(*(const __attribute__((address_space(3))) bf16x8*)(vq0 + (vs) + D0 * 2048), *(const __attribute__((address_space(3))) bf16x8*)(vq1 + (vs) + D0 * 2048)); } while (0)
#define PVM8() do { asm volatile("" : "+v"(P8)); _Pragma("unroll") for (int D0 = 0; D0 < 4; ++D0) asm volatile("" : "+v"(vf[D0])); \
    asm volatile("v_mfma_scale_f32_32x32x64_f8f6f4 %0, %1, %2, %0, %3, %3 op_sel_hi:[0,0,0]" : "+v"(lsum) : "v"(P8), "v"(ones8), "v"(sc8)); \
    _Pragma("unroll") for (int D0 = 0; D0 < 4; ++D0) asm volatile("v_mfma_scale_f32_32x32x64_f8f6f4 %0, %1, %2, %0, %3, %3 op_sel_hi:[0,0,0]" : "+v"(o[D0]) : "v"(P8), "v"(vf[D0]), "v"(sc8)); } while (0)
  WAIT_BAR();
  KLD8(0); QKM8();
  asm volatile("s_nop 15\n\ts_nop 15" : "+v"(p0), "+v"(p1), "+v"(negm));
  softmax_seg8<true>(p0, p1, mhat, negm, lsum, o, wsf, r32, hi, P8);
  if (half) BAR_ONLY();
  int ks_next = KSLOT, vs_cur = 0;
#pragma unroll 1
  for (int j = 0; j < NT - 1; ++j) {
    __builtin_amdgcn_s_setprio(3);
    SBAR(); KLD8(ks_next); V8LD(vs_cur); SBAR();
    QKM8();
    PVM8();
    SBAR(); __builtin_amdgcn_s_setprio(0);
    WAIT_BAR();
    if (j + 3 < NT) DMA_K(j + 3, (ks_next == KSLOT) ? 0 : ((ks_next == 2 * KSLOT) ? KSLOT : 2 * KSLOT));
    if (j + 2 < NT) DMA_V(j + 2, (vs_cur == 0) ? 2 * VSLOT : vs_cur - VSLOT);
    ks_next = (ks_next == 2 * KSLOT) ? 0 : ks_next + KSLOT; vs_cur = (vs_cur == 2 * VSLOT) ? 0 : vs_cur + VSLOT;
    softmax_seg8<false>(p0, p1, mhat, negm, lsum, o, wsf, r32, hi, P8);
    LGKM_BAR();
  }
  { __builtin_amdgcn_s_setprio(3); SBAR(); V8LD(vs_cur); SBAR(); PVM8(); SBAR(); __builtin_amdgcn_s_setprio(0); WAIT_BAR(); }
  if (!half) BAR_ONLY();
  asm volatile("s_nop 15\n\ts_nop 15" : "+v"(o[0]), "+v"(o[1]), "+v"(o[2]), "+v"(o[3]), "+v"(lsum));
#undef DMA_K
#undef DMA_V
#undef KLD8
#undef QKM8
#undef V8LD
#undef PVM8
}
__device__ __forceinline__ void attn_unit_88(int b, int h, int qb, const bf16_t* Vall, const unsigned char* V8T, const unsigned char* K8A, const unsigned char* K8B, const unsigned char* Q8A, const unsigned char* Q8B, bf16_t* O, const float* subw, float lam, float* stash, char* lds) {
  const int tid = threadIdx.x, wid = tid >> 6, lane = tid & 63, r32 = lane & 31, hi = lane >> 5;
  const long qrow0 = (long)b * SEQ + qb * 256 + wid * QBLK;
  const bf16_t* Vh = Vall + (long)b * SK * DM + h * 128;
  f32x16 o[4], lsum;
#pragma unroll 1
  for (int c = 0; c < 2; ++c) {
    const unsigned char* q8p = (c ? Q8B : Q8A) + ((size_t)(qrow0 + r32) * NH + h) * 64 + hi * 32; const unsigned char* k8p = (c ? K8B : K8A) + (size_t)(b * NH + h) * NT * 4096;
    flash_pass8(q8p, k8p, V8T + (size_t)(b * NH + h) * NT * 8192, lds, o, lsum);
#pragma unroll
    for (int r = 0; r < 16; ++r) { const float rl = __builtin_amdgcn_rcpf(lsum[r]);
#pragma unroll
      for (int d0 = 0; d0 < 4; ++d0) o[d0][r] *= rl; }
    int tt = tid; asm volatile("" : "+v"(tt));
    float* stl = stash + tt;
    if (c == 0) {
#pragma unroll
      for (int d0 = 0; d0 < 4; ++d0)
#pragma unroll
        for (int r = 0; r < 16; ++r) stl[(d0 * 16 + r) * 512] = o[d0][r];
    } else {
      const int ll = tt & 63, r32l = ll & 31, hil = ll >> 5;
      float ss[16];
#pragma unroll
      for (int r = 0; r < 16; ++r) ss[r] = 0.f;
#pragma unroll
      for (int d0 = 0; d0 < 4; ++d0) {
#pragma unroll
        for (int r = 0; r < 16; ++r) { const float v0 = stl[(d0 * 16 + r) * 512] - lam * o[d0][r]; o[d0][r] = v0; ss[r] += v0 * v0; }
        asm volatile("" ::: "memory"); }
#pragma unroll
      for (int r = 0; r < 16; ++r) { float s = ss[r];
        s += __uint_as_float(__builtin_amdgcn_ds_swizzle(__float_as_uint(s), (1 << 10) | 0x1f)); s += __uint_as_float(__builtin_amdgcn_ds_swizzle(__float_as_uint(s), (2 << 10) | 0x1f));
        s += __uint_as_float(__builtin_amdgcn_ds_swizzle(__float_as_uint(s), (4 << 10) | 0x1f)); s += __uint_as_float(__builtin_amdgcn_ds_swizzle(__float_as_uint(s), (8 << 10) | 0x1f));
        s += __uint_as_float(__builtin_amdgcn_ds_swizzle(__float_as_uint(s), (16 << 10) | 0x1f));
        ss[r] = rsqrtf(s * (1.0f / 128.0f) + EPS) * (1.0f - LAM_INIT); }
      asm volatile("s_waitcnt lgkmcnt(0)" ::: "memory");
      bf16_t* stg = (bf16_t*)(lds + (tt >> 6) * 8192);
      bf16_t* stgl = stg + hil * 4 * 128 + r32l;
#pragma unroll
      for (int d0 = 0; d0 < 4; ++d0) { const float sw = subw[32 * d0 + r32l];
#pragma unroll
        for (int r = 0; r < 16; ++r) { const unsigned w = cvtpk(o[d0][r] * ss[r] * sw, 0.f); stgl[((r & 3) + 8 * (r >> 2)) * 128 + 32 * d0] = (bf16_t)w; } }
      asm volatile("s_waitcnt lgkmcnt(0)" ::: "memory");
      bf16_t* Ow = O + (qrow0 + (ll >> 4)) * DM + h * 128 + (ll & 15) * 8; const bf16_t* srd = stg + (ll >> 4) * 128 + (ll & 15) * 8;
#pragma unroll
      for (int i = 0; i < 8; ++i) { const u32x4 v = *(const u32x4*)(srd + i * 4 * 128); *(u32x4*)(Ow + (long)i * 4 * DM) = v; }
    }
    asm volatile("s_waitcnt vmcnt(0) lgkmcnt(0)\n\ts_barrier" ::: "memory");
  }
}

typedef float f32x4a __attribute__((ext_vector_type(4)));
#define MF16(a, b, c) __builtin_amdgcn_mfma_f32_16x16x32_bf16(a, b, c, 0, 0, 0)
__device__ __forceinline__ float xg_max(float v) {
  v = fmaxf(v, __uint_as_float(__builtin_amdgcn_ds_swizzle(__float_as_uint(v), (16 << 10) | 0x1f)));
  auto rr = __builtin_amdgcn_permlane32_swap(__float_as_uint(v), __float_as_uint(v), false, false); return fmaxf(__uint_as_float(rr[0]), __uint_as_float(rr[1])); }
__device__ __forceinline__ float xg_sum(float v) {
  v += __uint_as_float(__builtin_amdgcn_ds_swizzle(__float_as_uint(v), (16 << 10) | 0x1f));
  auto rr = __builtin_amdgcn_permlane32_swap(__float_as_uint(v), __float_as_uint(v), false, false); return __uint_as_float(rr[0]) + __uint_as_float(rr[1]); }
__device__ __forceinline__ float max4(f32x4a v) { return fmaxf(fmaxf(v[0], v[1]), fmaxf(v[2], v[3])); }

template <bool FIRST>
__device__ __forceinline__ void softmax_seg16(f32x4a (&s)[2][4], float (&mhat)[2], f32x4a (&negm)[2], f32x4a (&lacc)[2], f32x4a (&o)[2][8], bf16x8 (&pa)[2][2]) {
  if (FIRST) {
#pragma unroll
    for (int qb = 0; qb < 2; ++qb) {
      const float rm = xg_max(fmaxf(fmaxf(max4(s[qb][0]), max4(s[qb][1])), fmaxf(max4(s[qb][2]), max4(s[qb][3]))));
      mhat[qb] += rm;
#pragma unroll
      for (int kb = 0; kb < 4; ++kb) s[qb][kb] -= rm;
#pragma unroll
      for (int i = 0; i < 4; ++i) negm[qb][i] = -mhat[qb];
    }
    asm volatile("" : "+v"(negm[0]), "+v"(negm[1]));
  }
#pragma unroll
  for (int qb = 0; qb < 2; ++qb)
#pragma unroll
    for (int kb = 0; kb < 4; ++kb)
#pragma unroll
      for (int i = 0; i < 4; ++i) s[qb][kb][i] = __builtin_amdgcn_exp2f(s[qb][kb][i]);
  if (!FIRST && __builtin_expect(__any(fmaxf(lacc[0][0], lacc[1][0]) > L_THR), 0)) {
#pragma unroll
    for (int qb = 0; qb < 2; ++qb) {
      const float dl = fmaxf(ceilf(__builtin_amdgcn_logf(lacc[qb][0])), 0.f), f = __builtin_amdgcn_exp2f(-dl);
      mhat[qb] += dl; lacc[qb] *= f;
#pragma unroll
      for (int kb = 0; kb < 4; ++kb) s[qb][kb] *= f;
#pragma unroll
      for (int i = 0; i < 4; ++i) negm[qb][i] = -mhat[qb];
#pragma unroll
      for (int db = 0; db < 8; ++db) o[qb][db] *= f;
    }
    asm volatile("" : "+v"(negm[0]), "+v"(negm[1]));
  }
#pragma unroll
  for (int qb = 0; qb < 2; ++qb)
#pragma unroll
    for (int st = 0; st < 2; ++st) { u32x4 w = {cvtpk_s(s[qb][2 * st][0], s[qb][2 * st][1]), cvtpk_s(s[qb][2 * st][2], s[qb][2 * st][3]), cvtpk_s(s[qb][2 * st + 1][0], s[qb][2 * st + 1][1]), cvtpk_s(s[qb][2 * st + 1][2], s[qb][2 * st + 1][3])};
      pa[qb][st] = *reinterpret_cast<bf16x8*>(&w); }
}

__device__ __forceinline__ void flash_pass16(const bf16_t* __restrict__ Qrow, const bf16_t* __restrict__ Kh, const bf16_t* __restrict__ Vh, char* lds, f32x4a (&o)[2][8], float (&l_out)[2]) {
  int tid = threadIdx.x; asm volatile("" : "+v"(tid));
  const int lane = tid & 63, l15 = lane & 15, g = lane >> 4; const int wid = __builtin_amdgcn_readfirstlane(tid >> 6), half = wid >> 2;
  const unsigned lds0 = (unsigned)(uintptr_t)lds;
  const bf16_t* ksrc = Kh + (long)(16 * (wid >> 1) + (lane >> 2)) * DM + (wid & 1) * 32 + (((lane & 3) ^ ((lane >> 4) & 3))) * 8;
  const bf16_t* vsrc = Vh + (long)(16 * (wid & 3) + (lane >> 2)) * DM + (wid >> 2) * 32 + (((lane & 3) ^ (2 * ((lane >> 4) & 1)))) * 8;
  const unsigned kdst = lds0 + R_K + wid * 1024, vdst = lds0 + R_V + wid * 1024;
#define DMA_K(t, slot) glds16(ksrc + (long)(t) * KVBLK * DM, (unsigned)__builtin_amdgcn_readfirstlane(kdst + (slot)))
#define DMA_V(t, slot) do { glds16(vsrc + (long)(t) * KVBLK * DM, (unsigned)__builtin_amdgcn_readfirstlane(vdst + (slot))); glds16(vsrc + (long)(t) * KVBLK * DM + 64, (unsigned)__builtin_amdgcn_readfirstlane(vdst + (slot) + 8192)); } while (0)
  const lds_cptr shm3 = (lds_cptr)lds;
  const lds_cptr kp = shm3 + R_K + l15 * 64 + ((g ^ ((l15 >> 2) & 3)) * 16);
  const lds_cptr vpl = shm3 + R_V + (4 * g + (l15 >> 2)) * 64 + (l15 & 3) * 8;
  const lds_cptr vpe0 = vpl + (g & 1) * 32, vpo0 = vpl + ((g & 1) ^ 1) * 32;
  DMA_K(0, 0); DMA_K(1, KSLOT); DMA_V(0, 0); DMA_K(2, 2 * KSLOT); DMA_V(1, VSLOT);
  bf16x8 qr[4];
#pragma unroll
  for (int i = 0; i < 4; ++i) qr[i] = *reinterpret_cast<const bf16x8*>(Qrow + (long)(i >> 1) * 16 * DM + (i & 1) * 32);
  float z; asm volatile("v_mov_b32 %0, 0" : "=v"(z));
#pragma unroll
  for (int qb = 0; qb < 2; ++qb)
#pragma unroll
    for (int db = 0; db < 8; ++db)
#pragma unroll
      for (int i = 0; i < 4; ++i) o[qb][db][i] = z;
  float mhat[2] = {0.f, 0.f}; f32x4a negm[2], lacc[2];
#pragma unroll
  for (int qb = 0; qb < 2; ++qb)
#pragma unroll
    for (int i = 0; i < 4; ++i) { negm[qb][i] = z; lacc[qb][i] = z; }
  const bf16x8 ones = {0x3f80, 0x3f80, 0x3f80, 0x3f80, 0x3f80, 0x3f80, 0x3f80, 0x3f80};
  f32x4a s[2][4]; bf16x8 pa[2][2];
  bf16x8 kf[8]; s16x4 va[8], vb[8], vc[8];
#define KLD16(slot) do { _Pragma("unroll") for (int ks = 0; ks < 2; ++ks) { _Pragma("unroll") for (int kb = 0; kb < 4; ++kb) kf[2 * kb + ks] = *(const __attribute__((address_space(3))) bf16x8*)(kp + (slot) + (2 * kb + ks) * 1024); } } while (0)
#define QKM16() do { _Pragma("unroll") for (int kb = 0; kb < 4; ++kb) { s[0][kb] = MF16(kf[2 * kb], qr[0], negm[0]); s[1][kb] = MF16(kf[2 * kb], qr[2], negm[1]); } \
    _Pragma("unroll") for (int kb = 0; kb < 4; ++kb) { s[0][kb] = MF16(kf[2 * kb + 1], qr[1], s[0][kb]); s[1][kb] = MF16(kf[2 * kb + 1], qr[3], s[1][kb]); } } while (0)
#define VLD16(BUF, vpe, vpo, D0) do { _Pragma("unroll") for (int st = 0; st < 2; ++st) { _Pragma("unroll") for (int dbl = 0; dbl < 2; ++dbl) { const lds_cptr q_ = (dbl ? (vpo) : (vpe)) + ((D0) >> 1) * 8192 + ((D0) & 1) * 4096 + st * 2048; \
      BUF[(2 * st + dbl) * 2] = vtr(q_); BUF[(2 * st + dbl) * 2 + 1] = vtr(q_ + 1024); } } } while (0)
#define VFRG16(BUF, st, dbl) ((bf16x8){BUF[(2 * (st) + (dbl)) * 2][0], BUF[(2 * (st) + (dbl)) * 2][1], BUF[(2 * (st) + (dbl)) * 2][2], BUF[(2 * (st) + (dbl)) * 2][3], BUF[(2 * (st) + (dbl)) * 2 + 1][0], BUF[(2 * (st) + (dbl)) * 2 + 1][1], BUF[(2 * (st) + (dbl)) * 2 + 1][2], BUF[(2 * (st) + (dbl)) * 2 + 1][3]})
#define PVM16(BUF, D0) do { _Pragma("unroll") for (int st = 0; st < 2; ++st) { _Pragma("unroll") for (int dbl = 0; dbl < 2; ++dbl) { \
      o[0][2 * (D0) + dbl] = MF16(VFRG16(BUF, st, dbl), pa[0][st], o[0][2 * (D0) + dbl]); o[1][2 * (D0) + dbl] = MF16(VFRG16(BUF, st, dbl), pa[1][st], o[1][2 * (D0) + dbl]); } } } while (0)
#define LSUM16() do { lacc[0] = MF16(ones, pa[0][0], lacc[0]); lacc[1] = MF16(ones, pa[1][0], lacc[1]); lacc[0] = MF16(ones, pa[0][1], lacc[0]); lacc[1] = MF16(ones, pa[1][1], lacc[1]); } while (0)
  WAIT_BAR();
  KLD16(0); QKM16();
  softmax_seg16<true>(s, mhat, negm, lacc, o, pa);
  if (half) BAR_ONLY();
  int ks_next = KSLOT, vs_cur = 0;
#pragma unroll 1
  for (int j = 0; j < NT - 1; ++j) {
    { const lds_cptr vpe = vpe0 + vs_cur, vpo = vpo0 + vs_cur;
      __builtin_amdgcn_s_setprio(3);
      SBAR();
      KLD16(ks_next); VLD16(va, vpe, vpo, 0); VLD16(vb, vpe, vpo, 1);
      LSUM16();
      QKM16();
      VLD16(vc, vpe, vpo, 2);
      PVM16(va, 0);
      VLD16(va, vpe, vpo, 3);
      PVM16(vb, 1); PVM16(vc, 2); PVM16(va, 3);
      __builtin_amdgcn_sched_group_barrier(0x100, 4, 0);
#pragma unroll
      for (int g_ = 0; g_ < 36; ++g_) { __builtin_amdgcn_sched_group_barrier(0x8, 1, 0); __builtin_amdgcn_sched_group_barrier(0x100, 1, 0); }
#pragma unroll
      for (int g_ = 0; g_ < 16; ++g_) __builtin_amdgcn_sched_group_barrier(0x8, 1, 0);
      SBAR(); }
    __builtin_amdgcn_s_setprio(0);
    WAIT_BAR();
    if (j + 3 < NT) DMA_K(j + 3, (ks_next == KSLOT) ? 0 : ((ks_next == 2 * KSLOT) ? KSLOT : 2 * KSLOT));
    if (j + 2 < NT) DMA_V(j + 2, (vs_cur == 0) ? 2 * VSLOT : vs_cur - VSLOT);
    ks_next = (ks_next == 2 * KSLOT) ? 0 : ks_next + KSLOT; vs_cur = (vs_cur == 2 * VSLOT) ? 0 : vs_cur + VSLOT;
    softmax_seg16<false>(s, mhat, negm, lacc, o, pa);
    LGKM_BAR();
  }
  { const lds_cptr vpe = vpe0 + vs_cur, vpo = vpo0 + vs_cur;
    __builtin_amdgcn_s_setprio(3);
    SBAR(); VLD16(va, vpe, vpo, 0); VLD16(vb, vpe, vpo, 1); LSUM16();
    SBAR(); PVM16(va, 0); VLD16(va, vpe, vpo, 2);
    SBAR(); PVM16(vb, 1); VLD16(vb, vpe, vpo, 3);
    SBAR(); PVM16(va, 2);
    SBAR(); PVM16(vb, 3); SBAR(); __builtin_amdgcn_s_setprio(0); WAIT_BAR(); }
  if (!half) BAR_ONLY();
  l_out[0] = lacc[0][0]; l_out[1] = lacc[1][0];
#undef DMA_K
#undef DMA_V
#undef KLD16
#undef QKM16
#undef VLD16
#undef VFRG16
#undef PVM16
#undef LSUM16
}

constexpr int STG_PITCH = 272;
__device__ __forceinline__ void attn_unit16(int b, int h, int qb_, const bf16_t* Q, const bf16_t* Kall, const bf16_t* Vall, bf16_t* O, const float* subw, float lam, float* stash, char* lds) {
  const int tid = threadIdx.x, wid = tid >> 6, lane = tid & 63, l15 = lane & 15, g = lane >> 4;
  const long qrow0 = (long)b * SEQ + qb_ * 256 + wid * QBLK;
  const bf16_t* Vh = Vall + (long)b * SK * DM + h * 128;
  f32x4a o[2][8]; float l2[2];
#pragma unroll 1
  for (int c = 0; c < 2; ++c) {
    const bf16_t* Qrow = Q + (qrow0 + l15) * DM + h * 128 + c * 64 + g * 8;
    const bf16_t* Kh = Kall + (long)b * SK * DM + h * 128 + c * 64;
    flash_pass16(Qrow, Kh, Vh, lds, o, l2);
#pragma unroll
    for (int qb = 0; qb < 2; ++qb) { const float rl = __builtin_amdgcn_rcpf(l2[qb]);
#pragma unroll
      for (int db = 0; db < 8; ++db) o[qb][db] *= rl; }
    int tt = tid; asm volatile("" : "+v"(tt));
    float* stl = stash + tt;
    if (c == 0) {
#pragma unroll
      for (int qb = 0; qb < 2; ++qb)
#pragma unroll
        for (int db = 0; db < 8; ++db)
#pragma unroll
          for (int i = 0; i < 4; ++i) stl[((qb * 8 + db) * 4 + i) * 512] = o[qb][db][i];
    } else {
      const int ll = tt & 63, l15l = ll & 15, gl = ll >> 4;
      float rs[2];
#pragma unroll
      for (int qb = 0; qb < 2; ++qb) { float ss = 0.f;
#pragma unroll
        for (int db = 0; db < 8; ++db) {
#pragma unroll
          for (int i = 0; i < 4; ++i) { const float v0 = stl[((qb * 8 + db) * 4 + i) * 512] - lam * o[qb][db][i]; o[qb][db][i] = v0; ss += v0 * v0; }
          if ((db & 3) == 3) asm volatile("" ::: "memory"); }
        rs[qb] = rsqrtf(xg_sum(ss) * (1.0f / 128.0f) + EPS) * (1.0f - LAM_INIT); }
      asm volatile("s_waitcnt lgkmcnt(0)" ::: "memory");
      char* stg = lds + (tt >> 6) * (32 * STG_PITCH);
#pragma unroll
      for (int db = 0; db < 8; ++db) { const f32x4a sw = *(const f32x4a*)(subw + 16 * db + 4 * gl);
#pragma unroll
        for (int qb = 0; qb < 2; ++qb) { const f32x4a v = o[qb][db] * rs[qb] * sw;
          unsigned long long w = (unsigned long long)cvtpk(v[0], v[1]) | ((unsigned long long)cvtpk(v[2], v[3]) << 32);
          *(unsigned long long*)(stg + (16 * qb + l15l) * STG_PITCH + 32 * db + 8 * gl) = w; } }
      asm volatile("s_waitcnt lgkmcnt(0)" ::: "memory");
      bf16_t* Ow = O + (qrow0 + (ll >> 4)) * DM + h * 128 + (ll & 15) * 8; const char* srd = stg + (ll >> 4) * STG_PITCH + (ll & 15) * 16;
#pragma unroll
      for (int i = 0; i < 8; ++i) { const u32x4 v = *(const u32x4*)(srd + i * 4 * STG_PITCH); *(u32x4*)(Ow + (long)i * 4 * DM) = v; }
    }
    asm volatile("s_waitcnt vmcnt(0) lgkmcnt(0)\n\ts_barrier" ::: "memory");
  }
}
#undef MF16

__device__ __forceinline__ void attn_unit_mix(int b, int h, int qb_, const bf16_t* Q, const bf16_t* Kall, const bf16_t* Vall, const unsigned char* V8T, const unsigned char* K8, const unsigned char* Q8, bf16_t* O, const float* subw, float lam, float* stash, char* lds) {
  const int tid = threadIdx.x, wid = __builtin_amdgcn_readfirstlane(tid >> 6);
  const long qrow0 = (long)b * SEQ + qb_ * 256 + wid * QBLK;
  const bf16_t* Vh = Vall + (long)b * SK * DM + h * 128;
  {
    int t0 = threadIdx.x; asm volatile("" : "+v"(t0));
    const bf16_t* Qrow = Q + (qrow0 + (t0 & 15)) * DM + h * 128 + ((t0 >> 4) & 3) * 8;
    const bf16_t* Kh = Kall + (long)b * SK * DM + h * 128;
    f32x4a o[2][8]; float l2[2];
    flash_pass16(Qrow, Kh, Vh, lds, o, l2);
#pragma unroll
    for (int qb = 0; qb < 2; ++qb) { const float rl = __builtin_amdgcn_rcpf(l2[qb]);
#pragma unroll
      for (int db = 0; db < 8; ++db) o[qb][db] *= rl; }
    int tt = tid; asm volatile("" : "+v"(tt));
    float* st = stash + (size_t)((tt >> 6) * 32 + (tt & 15)) * 128 + ((tt >> 4) & 3) * 4;
#pragma unroll
    for (int qb = 0; qb < 2; ++qb)
#pragma unroll
      for (int db = 0; db < 8; ++db) *(f32x4a*)(st + qb * 16 * 128 + db * 16) = o[qb][db];
    asm volatile("s_waitcnt vmcnt(0) lgkmcnt(0)\n\ts_barrier" ::: "memory");
  }
  {
    int t1 = threadIdx.x; asm volatile("" : "+v"(t1));
    const int r32 = t1 & 31, hi = (t1 >> 5) & 1;
    f32x16 o[4], lsum;
    flash_pass8(Q8 + ((size_t)(qrow0 + r32) * NH + h) * 64 + hi * 32, K8 + (size_t)(b * NH + h) * NT * 4096, V8T + (size_t)(b * NH + h) * NT * 8192, lds, o, lsum);
#pragma unroll
    for (int r = 0; r < 16; ++r) { const float rl = __builtin_amdgcn_rcpf(lsum[r]);
#pragma unroll
      for (int d0 = 0; d0 < 4; ++d0) o[d0][r] *= rl; }
    int tt = tid; asm volatile("" : "+v"(tt));
    const int ll = tt & 63, r32l = ll & 31, hil = ll >> 5;
    const float* sr = stash + (size_t)((tt >> 6) * 32 + 4 * hil) * 128 + r32l;
    float ss[16];
#pragma unroll
    for (int r = 0; r < 16; ++r) ss[r] = 0.f;
#pragma unroll
    for (int d0 = 0; d0 < 4; ++d0) {
#pragma unroll
      for (int r = 0; r < 16; ++r) { const float v0 = sr[((r & 3) + 8 * (r >> 2)) * 128 + 32 * d0] - lam * o[d0][r]; o[d0][r] = v0; ss[r] += v0 * v0; }
      asm volatile("" ::: "memory"); }
#pragma unroll
    for (int r = 0; r < 16; ++r) { float s = ss[r];
      s += __uint_as_float(__builtin_amdgcn_ds_swizzle(__float_as_uint(s), (1 << 10) | 0x1f)); s += __uint_as_float(__builtin_amdgcn_ds_swizzle(__float_as_uint(s), (2 << 10) | 0x1f));
      s += __uint_as_float(__builtin_amdgcn_ds_swizzle(__float_as_uint(s), (4 << 10) | 0x1f)); s += __uint_as_float(__builtin_amdgcn_ds_swizzle(__float_as_uint(s), (8 << 10) | 0x1f));
      s += __uint_as_float(__builtin_amdgcn_ds_swizzle(__float_as_uint(s), (16 << 10) | 0x1f));
      ss[r] = rsqrtf(s * (1.0f / 128.0f) + EPS) * (1.0f - LAM_INIT); }
    asm volatile("s_waitcnt lgkmcnt(0)" ::: "memory");
    bf16_t* stg = (bf16_t*)(lds + (tt >> 6) * 8192);
    bf16_t* stgl = stg + hil * 4 * 128 + r32l;
#pragma unroll
    for (int d0 = 0; d0 < 4; ++d0) { const float sw = subw[32 * d0 + r32l];
#pragma unroll
      for (int r = 0; r < 16; ++r) { const unsigned w = cvtpk(o[d0][r] * ss[r] * sw, 0.f); stgl[((r & 3) + 8 * (r >> 2)) * 128 + 32 * d0] = (bf16_t)w; } }
    asm volatile("s_waitcnt lgkmcnt(0)" ::: "memory");
    bf16_t* Ow = O + (qrow0 + (ll >> 4)) * DM + h * 128 + (ll & 15) * 8; const bf16_t* srd = stg + (ll >> 4) * 128 + (ll & 15) * 8;
#pragma unroll
    for (int i = 0; i < 8; ++i) { const u32x4 v = *(const u32x4*)(srd + i * 4 * 128); *(u32x4*)(Ow + (long)i * 4 * DM) = v; }
    asm volatile("s_waitcnt vmcnt(0) lgkmcnt(0)\n\ts_barrier" ::: "memory");
  }
}
#undef BAR_ONLY
#undef WAIT_BAR
#undef LGKM_BAR
#undef SBAR
}

constexpr int NWAVES = 8;
constexpr size_t MiB = 1u << 20;
constexpr size_t WS_CTL = 0, CTL_ZERO_BYTES = 1 * MiB;
constexpr size_t WS_MOD = 1 * MiB;
constexpr size_t WS_ROPE = WS_MOD + 256 * 1024;
constexpr size_t WS_WSB = WS_ROPE + 64 * 1024;
constexpr size_t WS_TOKE = 2 * MiB;
constexpr size_t WS_TOKG = WS_TOKE + 256 * 1024;
constexpr size_t WS_CNT = WS_TOKG + 256 * 1024;
constexpr size_t WS_PANE = WS_CNT + 16 * 1024;
constexpr size_t WS_PANV = WS_PANE + 2048;
constexpr size_t WS_NPAN = WS_PANV + 2048;
constexpr size_t WS_TSLOT = 3 * MiB;
constexpr size_t WS_WQKV = 8 * MiB, WS_WO = 14 * MiB, WS_WGU = 16 * MiB, WS_WD = 27 * MiB, WS_WIN = 33 * MiB, WS_WOUT = 41 * MiB;
constexpr size_t WS_MGU = 45 * MiB, WS_MD = 157 * MiB, WS_ACT = 213 * MiB;
constexpr size_t WS_A = WS_ACT;
constexpr size_t WS_Q = WS_A + 65 * MiB, WS_K = WS_Q + 64 * MiB, WS_V = WS_K + 65 * MiB;
constexpr size_t WS_STASH = WS_V + 65 * MiB;
constexpr size_t WS_HID = WS_Q;
constexpr size_t WS_Z = WS_Q;
constexpr size_t WS_V8T = 101 * MiB;
constexpr size_t WS_K8A = 520 * MiB, WS_Q8A = 504 * MiB;
constexpr size_t WS_K8 = 134 * MiB, WS_Q8 = 185 * MiB;
constexpr size_t WS_H8 = 101 * MiB;
constexpr size_t WS_AP8 = WS_A;
constexpr size_t WS_Y = WS_Q + 3 * MiB;
constexpr size_t WS_HM = WS_Y + 136 * MiB;
constexpr size_t HM_BYTES = (size_t)64 * 256 * EXD;
constexpr size_t WS_END = 537 * MiB;
static_assert(WS_HM + 2 * HM_BYTES <= WS_END && WS_V + (size_t)BATCH * SK * DM * 2 <= WS_END, "d_ws map");
constexpr int CW_BAR = 4096;
constexpr int MAX_PANELS = 272, PASS_PANELS = 64;
constexpr int RING_OFF = 0, RING_BYTES = 131072, LDSCTL_OFF = RING_BYTES, MISC_OFF = LDSCTL_OFF + 320, LDS_BYTES = 147456;
static_assert(att::LDS_BYTES <= RING_BYTES, "attention LDS");

#define GAS __attribute__((address_space(1)))
#define LAS __attribute__((address_space(3)))
typedef unsigned short bf16;
typedef unsigned v4u __attribute__((ext_vector_type(4)));
typedef float f32x4 __attribute__((ext_vector_type(4)));
typedef GAS unsigned gu32;
#define RLX_AGENT __ATOMIC_RELAXED, __HIP_MEMORY_SCOPE_AGENT
#define LDS_WAIT() asm volatile("s_waitcnt lgkmcnt(0)" ::: "memory")
#define VM_WAIT() asm volatile("s_waitcnt vmcnt(0)" ::: "memory")
__device__ __forceinline__ unsigned pk2(float lo, float hi) { unsigned r; asm volatile("v_cvt_pk_bf16_f32 %0, %1, %2" : "=v"(r) : "v"(lo), "v"(hi)); return r; }

#define XB_TMO      128
#define XB_XCNT(j)  (256  + 64 * (j))
#define XB_XSUB(j)  (1280 + 64 * (j))
#define XB_XGEN(j)  (2304 + 64 * (j))
#define XB_TOP      3328
#define XB_TOPGEN   3392
#define XCD_BAR_WORDS 3456
#define XB_SPIN_CAP (1u << 22)
__device__ __forceinline__ unsigned xb_ld(unsigned* p)              { return __hip_atomic_load(p, __ATOMIC_RELAXED, __HIP_MEMORY_SCOPE_AGENT); }
__device__ __forceinline__ unsigned xb_add(unsigned* p, unsigned v) { return __hip_atomic_fetch_add(p, v, __ATOMIC_RELAXED, __HIP_MEMORY_SCOPE_AGENT); }
__device__ __forceinline__ unsigned xb_xcc_id() { return (unsigned)__builtin_amdgcn_s_getreg((3 << 11) | 20) & 0xFu; }
#define XB_SPIN(cond, bar) do { unsigned _sp = 0; while (cond) { __builtin_amdgcn_s_sleep(1); \
    if ((++_sp & 255u) == 0u) { if (xb_ld(&(bar)[XB_TMO])) break; if (_sp > XB_SPIN_CAP) { atomicAdd(&(bar)[XB_TMO], 1u); break; } } } } while (0)
struct XcdBarrier { unsigned* bar; unsigned x; volatile LAS unsigned* st; };
__device__ __forceinline__ XcdBarrier xcd_barrier_post(unsigned* bar, volatile LAS unsigned* st) {
    XcdBarrier b; b.bar = bar; b.x = xb_xcc_id(); b.st = st;
    if (threadIdx.x == 0) (void)xb_add(&bar[XB_XCNT(b.x)], 1u);
    return b;
}
__device__ __forceinline__ void xcd_barrier_complete(unsigned* bar, unsigned x, unsigned& nloc, unsigned& nx) {
    const unsigned G = gridDim.x * gridDim.y * gridDim.z;
    unsigned sum, cnt, mine, sp = 0u;
    for (;;) {
        sum = 0u; cnt = 0u; mine = 0u;
#pragma unroll
        for (unsigned j = 0; j < 16; ++j) { const unsigned c = xb_ld(&bar[XB_XCNT(j)]); sum += c; cnt += (c > 0u) ? 1u : 0u; mine = (j == x) ? c : mine; }
        if (sum == G) break;
        __builtin_amdgcn_s_sleep(1);
        if ((++sp & 255u) == 0u) { if (xb_ld(&bar[XB_TMO])) break; if (sp > XB_SPIN_CAP) { atomicAdd(&bar[XB_TMO], 1u); break; } }
    }
    nloc = mine > 0u ? mine : 1u; nx = cnt > 0u ? cnt : 1u;
}
__device__ __forceinline__ void xcd_barrier(const XcdBarrier& b) {
    asm volatile("s_waitcnt vmcnt(0)" ::: "memory");
    __syncthreads();
    if (threadIdx.x == 0) {
        unsigned* bar = b.bar;
        __builtin_amdgcn_s_waitcnt(0);
        unsigned nloc = b.st[0], nx = b.st[1];
        if (nloc == 0u) { xcd_barrier_complete(bar, b.x, nloc, nx); b.st[0] = nloc; b.st[1] = nx; }
        const unsigned old = xb_add(&bar[XB_XSUB(b.x)], 1u);
        const unsigned gen = old / nloc;
        if (old + 1u == (gen + 1u) * nloc) {
            __builtin_amdgcn_fence(__ATOMIC_RELEASE, "agent");
            asm volatile("s_waitcnt vmcnt(0)" ::: "memory");
            const unsigned og = xb_add(&bar[XB_TOP], 1u);
            const unsigned tg = og / nx;
            if (og + 1u == (tg + 1u) * nx) xb_add(&bar[XB_TOPGEN], 1u);
            else XB_SPIN(xb_ld(&bar[XB_TOPGEN]) == tg, bar);
            __builtin_amdgcn_fence(__ATOMIC_ACQUIRE, "agent");
            xb_add(&bar[XB_XGEN(b.x)], 1u);
            asm volatile("s_waitcnt vmcnt(0)" ::: "memory");
        } else {
            XB_SPIN(xb_ld(&bar[XB_XGEN(b.x)]) == gen, bar);
            __builtin_amdgcn_fence(__ATOMIC_ACQUIRE, "agent");
            asm volatile("s_waitcnt vmcnt(0)" ::: "memory");
        }
    }
    __syncthreads();
}

#define DPP_ADD(v, CTRL, ROWMASK) ((v) + __int_as_float(__builtin_amdgcn_update_dpp(0, __float_as_int(v), (CTRL), (ROWMASK), 0xf, false)))
__device__ __forceinline__ float wave_sum(float v) {
    v = DPP_ADD(v, 0xB1, 0xf);
    v = DPP_ADD(v, 0x4E, 0xf);
    v = DPP_ADD(v, 0x141, 0xf);
    v = DPP_ADD(v, 0x140, 0xf);
    v = DPP_ADD(v, 0x142, 0xa);
    v = DPP_ADD(v, 0x143, 0xc);
    return __int_as_float(__builtin_amdgcn_readlane(__float_as_int(v), 63));
}
template <int KIND> __device__ __forceinline__ int dst_row(int n) {
    if (KIND == 0) return n;
    if (KIND == 1) { if (n >= 2048) return n; const int d = n & 63, ax = d >> 5, dd = d & 31, x2 = dd >> 4, f = dd & 15; return (n & ~63) + 8 * (4 * ax + (f >> 2)) + 4 * x2 + (f & 3); }
    if (KIND == 2) return (n >> 7) * 256 + (n & 127);
    return (n >> 7) * 256 + 128 + (n & 127);
}
template <int KIND> __device__ __forceinline__ void transpose_item(const float* W, int K, int N, bf16* WT, LAS float* scr, int item, int lane) {
    const int nblk = N / 32, kb = item / nblk, nb = item % nblk, k0 = 64 * kb, n0 = 32 * nb;
    { float wv[32];
#pragma unroll
      for (int i = 0; i < 32; ++i) wv[i] = W[(size_t)(k0 + 2 * i + (lane >> 5)) * N + n0 + (lane & 31)];
#pragma unroll
      for (int i = 0; i < 32; ++i) scr[(2 * i + (lane >> 5)) * 33 + (lane & 31)] = wv[i]; }
    LDS_WAIT(); asm volatile("" ::: "memory");
    const int c = lane & 7;
#pragma unroll
    for (int j = 0; j < 4; ++j) { const int n = (lane >> 3) + 8 * j; const LAS float* s = scr + (8 * c) * 33 + n;
        v4u o; o.x = pk2(s[0 * 33], s[1 * 33]); o.y = pk2(s[2 * 33], s[3 * 33]); o.z = pk2(s[4 * 33], s[5 * 33]); o.w = pk2(s[6 * 33], s[7 * 33]);
        *(GAS v4u*)(WT + (size_t)dst_row<KIND>(n0 + n) * K + k0 + 8 * c) = o; }
    LDS_WAIT(); asm volatile("" ::: "memory");
}
template <int KIND> __device__ __forceinline__ void transpose_item8(const float* W, int K, int N, unsigned char* WT, float wscale, LAS float* scr, int item, int lane) {
    const int nblk = N / 32, kb = item / nblk, nb = item % nblk, k0 = 64 * kb, n0 = 32 * nb;
    { float wv[32];
#pragma unroll
      for (int i = 0; i < 32; ++i) wv[i] = W[(size_t)(k0 + 2 * i + (lane >> 5)) * N + n0 + (lane & 31)];
#pragma unroll
      for (int i = 0; i < 32; ++i) scr[(2 * i + (lane >> 5)) * 33 + (lane & 31)] = wv[i] * wscale; }
    LDS_WAIT(); asm volatile("" ::: "memory");
    const int c = lane & 7;
#pragma unroll
    for (int j = 0; j < 4; ++j) { const int n = (lane >> 3) + 8 * j; const LAS float* s = scr + (8 * c) * 33 + n;
        int w0 = __builtin_amdgcn_cvt_pk_fp8_f32(s[0 * 33], s[1 * 33], 0, false); w0 = __builtin_amdgcn_cvt_pk_fp8_f32(s[2 * 33], s[3 * 33], w0, true);
        int w1 = __builtin_amdgcn_cvt_pk_fp8_f32(s[4 * 33], s[5 * 33], 0, false); w1 = __builtin_amdgcn_cvt_pk_fp8_f32(s[6 * 33], s[7 * 33], w1, true);
        *(GAS unsigned long long*)(WT + (size_t)dst_row<KIND>(n0 + n) * K + k0 + 8 * c) = (unsigned long long)(unsigned)w0 | ((unsigned long long)(unsigned)w1 << 32); }
    LDS_WAIT(); asm volatile("" ::: "memory");
}
template <int KIND> __device__ __forceinline__ void transpose_item6(const float* W, int K, int N, unsigned char* WT, LAS float* scr, int item, int lane) {
    const int nblk = N / 32, kb = item / nblk, nb = item % nblk, k0 = 64 * kb, n0 = 32 * nb;
    { float wv[32];
#pragma unroll
      for (int i = 0; i < 32; ++i) wv[i] = W[(size_t)(k0 + 2 * i + (lane >> 5)) * N + n0 + (lane & 31)];
#pragma unroll
      for (int i = 0; i < 32; ++i) scr[(2 * i + (lane >> 5)) * 33 + (lane & 31)] = wv[i]; }
    LDS_WAIT(); asm volatile("" ::: "memory");
    const int n = lane & 31, blk = lane >> 5; const LAS float* sp = scr + (32 * blk) * 33 + n;
    pg8::v16f32 x, y; float mx = 0.f;
#pragma unroll
    for (int i = 0; i < 16; ++i) { x[i] = sp[i * 33]; y[i] = sp[(16 + i) * 33]; mx = fmaxf(mx, fmaxf(fabsf(x[i]), fabsf(y[i]))); }
    const pg8::v8i32 ch = pg8::fp6_chunk(x, y, mx);
    const int k = k0 + 32 * blk; unsigned char* dst = WT + (size_t)dst_row<KIND>(n0 + n) * K + (k >> 7) * 128 + ((k >> 5) & 3) * 16;
    *(GAS v4u*)dst = (v4u){(unsigned)ch[0], (unsigned)ch[1], (unsigned)ch[2], (unsigned)ch[3]};
    *(GAS v4u*)(dst + 64) = (v4u){(unsigned)ch[4], (unsigned)ch[5], (unsigned)ch[6], (unsigned)ch[7]};
    LDS_WAIT(); asm volatile("" ::: "memory");
}
struct RowVec { f32x4 v[4]; };
__device__ __forceinline__ RowVec load_vec(const float* p, int lane) { RowVec r; const f32x4* q = (const f32x4*)p + lane;
#pragma unroll
    for (int j = 0; j < 4; ++j) r.v[j] = q[64 * j]; return r; }
__device__ __forceinline__ RowVec norm_row(const float* xrow, const RowVec& wn, int lane) {
    RowVec x = load_vec(xrow, lane); float s = 0.f;
#pragma unroll
    for (int j = 0; j < 4; ++j) s += (x.v[j].x * x.v[j].x + x.v[j].y * x.v[j].y) + (x.v[j].z * x.v[j].z + x.v[j].w * x.v[j].w);
    const float rs = rsqrtf(wave_sum(s) * (1.0f / DM) + EPS);
#pragma unroll
    for (int j = 0; j < 4; ++j) x.v[j] = x.v[j] * rs * wn.v[j];
    return x;
}
__device__ __forceinline__ void store_row_bf16(bf16* orow, const RowVec& y, int lane) {
    GAS unsigned long long* o8 = (GAS unsigned long long*)orow + lane;
#pragma unroll
    for (int j = 0; j < 4; ++j) o8[64 * j] = (unsigned long long)pk2(y.v[j].x, y.v[j].y) | ((unsigned long long)pk2(y.v[j].z, y.v[j].w) << 32);
}

__device__ __forceinline__ void norm_mod_rows(const float* src, bf16* dst, int nrows, int gw, int NGW, const RowVec& wn, const RowVec& sh, const RowVec& sc, int lane) {
    for (int m = gw; m < nrows; m += 4 * NGW) {
        RowVec x[4];
#pragma unroll
        for (int u = 0; u < 4; ++u) { const int r = m + u * NGW; x[u] = load_vec(src + (size_t)(r < nrows ? r : m) * DM, lane); }
#pragma unroll
        for (int u = 0; u < 4; ++u) { const int r = m + u * NGW; if (r < nrows) { float s = 0.f;
#pragma unroll
            for (int j = 0; j < 4; ++j) s += (x[u].v[j].x * x[u].v[j].x + x[u].v[j].y * x[u].v[j].y) + (x[u].v[j].z * x[u].v[j].z + x[u].v[j].w * x[u].v[j].w);
            const float rs = rsqrtf(wave_sum(s) * (1.0f / DM) + EPS);
#pragma unroll
            for (int j = 0; j < 4; ++j) x[u].v[j] = x[u].v[j] * rs * wn.v[j] * (1.0f + sc.v[j]) + sh.v[j];
            store_row_bf16(dst + (size_t)r * DM, x[u], lane); } }
    }
}

struct Args { const float* in[29]; float* out; unsigned char* ws; int ph_lo, ph_hi; };
constexpr int N_PHASES = 25;
constexpr int I_MGU_ = (DM / 64) * (EXD / 32), I_MD_ = (EXD / 64) * (DM / 32), MOE_ITEMS = NE * (2 * I_MGU_ + I_MD_);
__device__ __forceinline__ void moe_weight_item(const Args& args, unsigned char* ws, LAS float* scr, int r, int lane) {
    const int per_e = 2 * I_MGU_ + I_MD_, e = r / per_e; r -= e * per_e;
    if (r < I_MGU_) { transpose_item6<2>(args.in[26] + (size_t)e * DM * EXD, DM, EXD, (unsigned char*)(ws + WS_MGU) + (size_t)e * 2 * EXD * DM, scr, r, lane); return; } r -= I_MGU_;
    if (r < I_MGU_) { transpose_item6<3>(args.in[27] + (size_t)e * DM * EXD, DM, EXD, (unsigned char*)(ws + WS_MGU) + (size_t)e * 2 * EXD * DM, scr, r, lane); return; } r -= I_MGU_;
    transpose_item8<0>(args.in[28] + (size_t)e * EXD * DM, EXD, DM, (unsigned char*)(ws + WS_MD) + (size_t)e * DM * EXD, W8SCALE, scr, r, lane);
}
constexpr int QKV_UNITS = 130 * 12;
__device__ __forceinline__ int moe_tail_items(int G) { const int rem = QKV_UNITS % G, idle = (rem > 0) ? G - rem : 0; const int n = idle * NWAVES * 6; return n < MOE_ITEMS ? n : MOE_ITEMS; }

__global__ void __launch_bounds__(NWAVES * 64, 2) fwd_kernel(Args args) {
    extern __shared__ __attribute__((aligned(16))) unsigned char lds[];
    LAS unsigned char* ldsl = (LAS unsigned char*)lds;
    volatile LAS unsigned* MISC = (volatile LAS unsigned*)(ldsl + MISC_OFF);
    int tid = threadIdx.x, lane = tid & 63; const int wave = __builtin_amdgcn_readfirstlane(tid >> 6);
#define PHASE_BEGIN() asm volatile("" : "+v"(tid), "+v"(lane))
    const int G = gridDim.x, bx = blockIdx.x;
    const int vcu = (G % 8 == 0) ? (bx % 8) * (G / 8) + bx / 8 : bx;
    const int gw = vcu * NWAVES + wave, NGW = G * NWAVES;
    unsigned char* ws = args.ws;
    gu32* ctl = (gu32*)(ws + WS_CTL);
    for (int u = tid; u < (LDS_BYTES - LDSCTL_OFF) / 4; u += NWAVES * 64) ((LAS unsigned*)(ldsl + LDSCTL_OFF))[u] = 0u;
    __syncthreads();
    XcdBarrier bar; bar.bar = (unsigned*)(ctl + CW_BAR); bar.x = 0; bar.st = nullptr;
    if (MK_N_LAUNCHES == 1) bar = xcd_barrier_post((unsigned*)(ctl + CW_BAR), MISC + 8);
    const int lo = args.ph_lo, hi = args.ph_hi;
#ifndef PH_MASK
#define PH_MASK 0xffffffffu
#endif
#define IN(k) (((PH_MASK >> (k)) & 1u) && lo <= (k) && (k) < hi)
#define GRID_BAR() do { if (MK_N_LAUNCHES == 1) xcd_barrier(bar); } while (0)
    const float* x_in = args.in[0]; const float* c_in = args.in[1]; const float* ctx_in = args.in[2]; const float* cctx_in = args.in[3];
    const float* w_mod = args.in[4]; const float* b_mod = args.in[5]; const float* norm1_w = args.in[6]; const float* norm2_w = args.in[7]; const float* final_w = args.in[8];
    float* xres = args.out;
    float* MOD = (float*)(ws + WS_MOD); float* ROPE = (float*)(ws + WS_ROPE);
    bf16* ABUF = (bf16*)(ws + WS_A);
#define MODP(l, cond, chunk) (MOD + ((size_t)((l) * 3 + (cond)) * 6144 + (chunk) * 1024))

    if (IN(0)) { PHASE_BEGIN();
        if (vcu < 48) {
            const int l = vcu / 24, cb = vcu % 24;
            LAS float* sl = (LAS float*)(ldsl + RING_OFF);
            LAS float* red = sl + 3 * 1024;
            for (int i = tid; i < 3 * 1024; i += NWAVES * 64) { const int cd = i >> 10, k = i & 1023; const float v = cd < 2 ? c_in[cd * 1024 + k] : cctx_in[k]; sl[i] = v / (1.0f + __expf(-v)); }
            __syncthreads();
            f32x4 a0 = {0, 0, 0, 0}, a1 = a0, a2 = a0;
            const float* wp = w_mod + ((size_t)l * 1024 + wave * 128) * 6144 + cb * 256 + lane * 4;
#pragma unroll 16
            for (int k = 0; k < 128; ++k) { const f32x4 w = *(const f32x4*)(wp + (size_t)k * 6144); const int kk = wave * 128 + k; a0 += w * sl[kk]; a1 += w * sl[1024 + kk]; a2 += w * sl[2048 + kk]; }
            *(LAS f32x4*)(red + (wave * 3 + 0) * 256 + lane * 4) = a0; *(LAS f32x4*)(red + (wave * 3 + 1) * 256 + lane * 4) = a1; *(LAS f32x4*)(red + (wave * 3 + 2) * 256 + lane * 4) = a2;
            __syncthreads();
            for (int i = tid; i < 3 * 256; i += NWAVES * 64) { const int cd = i >> 8, cc = i & 255; float s = 0.f;
#pragma unroll
                for (int w = 0; w < 8; ++w) s += red[(w * 3 + cd) * 256 + cc];
                MOD[(size_t)(l * 3 + cd) * 6144 + cb * 256 + cc] = s + b_mod[l * 6144 + cb * 256 + cc]; }
            __syncthreads();
        } else if (vcu == 48) {
            for (int i = tid; i < 4096; i += NWAVES * 64) { const int pos = i >> 4, f = i & 15; const float inv = powf(10000.0f, -(float)f / 16.0f); const float ang = (float)pos * inv; ROPE[i] = cosf(ang); ROPE[4096 + i] = sinf(ang); }
        } else if (vcu == 49) {
            const float* wsrc = args.in[19]; bf16* wd = (bf16*)(ws + WS_WSB);
            for (int i = tid; i < 8 * 128 * 128 / 2; i += NWAVES * 64) ((unsigned*)wd)[i] = pk2(wsrc[2 * i], wsrc[2 * i + 1]);
        }
        LAS float* scr = (LAS float*)(ldsl + RING_OFF + 32768 + wave * 8704);
        {
            constexpr int I_QKV = (DM / 64) * (3072 / 32), I_O = (DM / 64) * (DM / 32), I_GU = (DM / 64) * (FFN / 32), I_D = (FFN / 64) * (DM / 32);
            constexpr int I_IN = (DM / 64) * (4096 / 32), I_OUT = (GMH / 64) * (DM / 32), I_MGU = (DM / 64) * (EXD / 32), I_MD = (EXD / 64) * (DM / 32);
            constexpr int NITEMS = I_QKV + I_O + 2 * I_GU + I_D + I_IN + I_OUT + NE * (2 * I_MGU + I_MD);
            const int nitems0 = NITEMS - moe_tail_items(G);
            for (int it = gw; it < nitems0; it += NGW) {
                int r = it;
                if (r < I_QKV) { transpose_item<1>(args.in[9], DM, 3072, (bf16*)(ws + WS_WQKV), scr, r, lane); continue; } r -= I_QKV;
                if (r < I_O) { transpose_item<0>(args.in[10], DM, DM, (bf16*)(ws + WS_WO), scr, r, lane); continue; } r -= I_O;
                if (r < I_GU) { transpose_item<2>(args.in[22], DM, FFN, (bf16*)(ws + WS_WGU), scr, r, lane); continue; } r -= I_GU;
                if (r < I_GU) { transpose_item<3>(args.in[23], DM, FFN, (bf16*)(ws + WS_WGU), scr, r, lane); continue; } r -= I_GU;
                if (r < I_D) { transpose_item<0>(args.in[24], FFN, DM, (bf16*)(ws + WS_WD), scr, r, lane); continue; } r -= I_D;
                if (r < I_IN) { transpose_item<0>(args.in[16], DM, 4096, (bf16*)(ws + WS_WIN), scr, r, lane); continue; } r -= I_IN;
                if (r < I_OUT) { transpose_item<0>(args.in[21], GMH, DM, (bf16*)(ws + WS_WOUT), scr, r, lane); continue; } r -= I_OUT;
                moe_weight_item(args, ws, scr, r, lane);
            }
        }
        GRID_BAR();
    }

    if (IN(1)) { PHASE_BEGIN();
        const RowVec wn = load_vec(norm1_w, lane);
        for (int b = 0; b < 3; ++b) {
            const RowVec sh = load_vec(MODP(0, b, 0), lane), sc = load_vec(MODP(0, b, 1), lane);
            const int nrows = b < 2 ? SEQ : BATCH * CTXL; const float* src = b < 2 ? x_in + (size_t)b * SEQ * DM : ctx_in; bf16* dst = ABUF + (size_t)(b < 2 ? b * SEQ : T) * DM;
            norm_mod_rows(src, dst, nrows, gw, NGW, wn, sh, sc, lane);
        }
        GRID_BAR();
    }

    if (IN(2)) { PHASE_BEGIN();
        pg8::Gemm g{ABUF, (const bf16*)(ws + WS_WQKV), DM, DM, DM}; pg8::StaticOrder S; S.init(130, 12, G, bx);
        pg8::EpiQKV E{(bf16*)(ws + WS_Q), (bf16*)(ws + WS_K), (bf16*)(ws + WS_V), ROPE, ROPE + 4096};
        pg8::gemm_phase(ldsl + RING_OFF, g, S, E);
        { const int rem = QKV_UNITS % G, tailn = moe_tail_items(G);
          if (tailn > 0 && bx >= rem) { LAS float* scr = (LAS float*)(ldsl + RING_OFF + 32768 + wave * 8704);
              for (int r = MOE_ITEMS - tailn + (bx - rem) * NWAVES + wave; r < MOE_ITEMS; r += (G - rem) * NWAVES) moe_weight_item(args, ws, scr, r, lane); } }
        GRID_BAR();
    }

    if (IN(3)) { PHASE_BEGIN();
        float lam;
        { const float a = args.in[11][lane] * args.in[12][lane], b2 = args.in[13][lane] * args.in[14][lane]; lam = __expf(wave_sum(a)) - __expf(wave_sum(b2)) + LAM_INIT; }
        const float* subw = args.in[15];
        { const bf16* Vall = (const bf16*)(ws + WS_V); unsigned char* V8T = (unsigned char*)(ws + WS_V8T);
          for (int it = gw; it < BATCH * NH * att::NT; it += NGW) {
              const int b = it / (NH * att::NT), rem = it - b * NH * att::NT, h = rem / att::NT, t = rem - h * att::NT;
              const bf16* src = Vall + ((size_t)b * SK + (size_t)t * 64) * DM + h * 128 + 2 * lane;
              unsigned w[64];
#pragma unroll
              for (int k = 0; k < 64; ++k) w[k] = *(const unsigned*)(src + (size_t)k * DM);
              unsigned char* dstt = V8T + (size_t)it * 8192;
#pragma unroll
              for (int dd = 0; dd < 2; ++dd) { const int d = 2 * lane + dd, sd = (d >> 2) & 3;
#pragma unroll
                  for (int c = 0; c < 4; ++c) { v4u o4;
#pragma unroll
                      for (int wq = 0; wq < 4; ++wq) { const int k0 = 32 * (c & 1) + 8 * wq + 4 * (c >> 1);
                          const float v0 = dd ? att::bf_hi(w[k0]) : att::bf_lo(w[k0]), v1 = dd ? att::bf_hi(w[k0 + 1]) : att::bf_lo(w[k0 + 1]), v2 = dd ? att::bf_hi(w[k0 + 2]) : att::bf_lo(w[k0 + 2]), v3 = dd ? att::bf_hi(w[k0 + 3]) : att::bf_lo(w[k0 + 3]);
                          int a = __builtin_amdgcn_cvt_pk_fp8_f32(v0, v1, 0, false); a = __builtin_amdgcn_cvt_pk_fp8_f32(v2, v3, a, true); o4[wq] = (unsigned)a; }
                      *(v4u*)(dstt + d * 64 + ((c ^ sd) * 16)) = o4; } }
          } }
        for (int cs = 0; cs < 2; ++cs)
        { const bf16* Kall = (const bf16*)(ws + WS_K); unsigned char* K8 = (unsigned char*)(ws + (cs ? WS_K8 : WS_K8A));
          for (int it = gw; it < BATCH * NH * att::NT; it += NGW) {
              const int b = it / (NH * att::NT), rem = it - b * NH * att::NT, h = rem / att::NT, t = rem - h * att::NT;
              const v4u* src = (const v4u*)(Kall + ((size_t)b * SK + (size_t)t * 64 + lane) * DM + h * 128 + cs * 64);
              v4u w8[8];
#pragma unroll
              for (int k = 0; k < 8; ++k) w8[k] = src[k];
              unsigned char* dstt = K8 + (size_t)it * 4096 + lane * 64; const int sd = (lane >> 2) & 3;
#pragma unroll
              for (int hh = 0; hh < 2; ++hh) {
                  pg8::v16f32 xe, xo; float mx = 0.f;
#pragma unroll
                  for (int i = 0; i < 16; ++i) { const unsigned w = w8[(16 * hh + i) >> 2][(16 * hh + i) & 3]; xe[i] = att::bf_lo(w); xo[i] = att::bf_hi(w); mx = fmaxf(mx, fmaxf(fabsf(xe[i]), fabsf(xo[i]))); }
                  const pg8::v8i32 c8 = pg8::fp6_chunk(xe, xo, mx);
                  *(v4u*)(dstt + (((2 * hh) ^ sd) * 16)) = (v4u){(unsigned)c8[0], (unsigned)c8[1], (unsigned)c8[2], (unsigned)c8[3]};
                  *(v4u*)(dstt + (((2 * hh + 1) ^ sd) * 16)) = (v4u){(unsigned)c8[4], (unsigned)c8[5], (unsigned)c8[6], (unsigned)c8[7]}; } }
          const bf16* Qb = (const bf16*)(ws + WS_Q); unsigned char* Q8 = (unsigned char*)(ws + (cs ? WS_Q8 : WS_Q8A));
          for (int idx = gw * 64 + lane; idx < T * NH; idx += NGW * 64) {
              const v4u* src = (const v4u*)(Qb + (size_t)(idx >> 3) * DM + (idx & 7) * 128 + cs * 64);
              v4u w8[8];
#pragma unroll
              for (int k = 0; k < 8; ++k) w8[k] = src[k];
#pragma unroll
              for (int hh = 0; hh < 2; ++hh) {
                  pg8::v16f32 xe, xo; float mx = 0.f;
#pragma unroll
                  for (int i = 0; i < 16; ++i) { const unsigned w = w8[(16 * hh + i) >> 2][(16 * hh + i) & 3]; xe[i] = att::bf_lo(w); xo[i] = att::bf_hi(w); mx = fmaxf(mx, fmaxf(fabsf(xe[i]), fabsf(xo[i]))); }
                  const pg8::v8i32 c8 = pg8::fp6_chunk(xe, xo, mx);
                  *(v4u*)(Q8 + (size_t)idx * 64 + hh * 32) = (v4u){(unsigned)c8[0], (unsigned)c8[1], (unsigned)c8[2], (unsigned)c8[3]};
                  *(v4u*)(Q8 + (size_t)idx * 64 + hh * 32 + 16) = (v4u){(unsigned)c8[4], (unsigned)c8[5], (unsigned)c8[6], (unsigned)c8[7]}; } } }
        GRID_BAR();
        for (int i = 0; i < 4; ++i) {
            const int bh = (vcu >> 5) * 2 + (i >> 1), qb = (vcu & 31) * 2 + (i & 1);
            att::attn_unit_88(bh >> 3, bh & 7, qb, (const bf16*)(ws + WS_V), (const unsigned char*)(ws + WS_V8T), (const unsigned char*)(ws + WS_K8A), (const unsigned char*)(ws + WS_K8), (const unsigned char*)(ws + WS_Q8A), (const unsigned char*)(ws + WS_Q8), ABUF, subw, lam, (float*)(ws + WS_STASH) + (size_t)bx * 64 * 512, (char*)lds + RING_OFF);
        }
        GRID_BAR();
    }

    if (IN(4)) { PHASE_BEGIN();
        pg8::Gemm g{ABUF, (const bf16*)(ws + WS_WO), DM, DM, DM}; pg8::StaticOrder S; S.init(128, 4, G, bx);
        pg8::EpiRes E{x_in, xres, MODP(0, 0, 2), 6144};
        pg8::gemm_phase(ldsl + RING_OFF, g, S, E);
        GRID_BAR();
    }
    if (IN(5)) { PHASE_BEGIN();
        const RowVec wn = load_vec(norm2_w, lane);
        for (int b = 0; b < 2; ++b) {
            const RowVec sh = load_vec(MODP(0, b, 3), lane), sc = load_vec(MODP(0, b, 4), lane);
            norm_mod_rows(xres + (size_t)b * SEQ * DM, ABUF + (size_t)b * SEQ * DM, SEQ, gw, NGW, wn, sh, sc, lane);
        }
        GRID_BAR();
    }
    if (IN(6)) { PHASE_BEGIN();
        pg8::Gemm g{ABUF, (const bf16*)(ws + WS_WGU), DM, DM, DM}; pg8::StaticOrder S; S.init(128, 22, G, bx);
        pg8::EpiSwiGLU E{(bf16*)(ws + WS_HID), FFN, 0, 1.0f, 1.0f};
        pg8::gemm_phase(ldsl + RING_OFF, g, S, E);
        GRID_BAR();
    }
    if (IN(7)) { PHASE_BEGIN();
        pg8::Gemm g{(const bf16*)(ws + WS_HID), (const bf16*)(ws + WS_WD), FFN, FFN, FFN}; pg8::StaticOrder S; S.init(128, 4, G, bx);
        pg8::EpiRes E{xres, xres, MODP(0, 0, 5), 6144};
        pg8::gemm_phase(ldsl + RING_OFF, g, S, E);
        GRID_BAR();
    }
    if (IN(8)) { PHASE_BEGIN();
        const RowVec wn = load_vec(norm1_w + DM, lane);
        for (int b = 0; b < 2; ++b) {
            const RowVec sh = load_vec(MODP(1, b, 0), lane), sc = load_vec(MODP(1, b, 1), lane);
            norm_mod_rows(xres + (size_t)b * SEQ * DM, ABUF + (size_t)b * SEQ * DM, SEQ, gw, NGW, wn, sh, sc, lane);
        }
        GRID_BAR();
    }
    if (IN(9)) { PHASE_BEGIN();
        pg8::Gemm g{ABUF, (const bf16*)(ws + WS_WIN), DM, DM, DM}; pg8::StaticOrder S; S.init(128, 16, G, bx);
        pg8::EpiGelu E{(bf16*)(ws + WS_Z), 4096};
        pg8::gemm_phase(ldsl + RING_OFF, g, S, E);
        GRID_BAR();
    }
    if (IN(10)) { PHASE_BEGIN();
        using att::bf16x8; using att::f32x16;
        bf16* Z = (bf16*)(ws + WS_Z); const bf16* WSB = (const bf16*)(ws + WS_WSB);
        const float* vnw = args.in[17]; const float* vnb = args.in[18]; const float* bs = args.in[20];
        LAS float* stat = (LAS float*)(ldsl + 132096);
        char* Vl = (char*)lds + RING_OFF;
        bf16* Sl = (bf16*)((char*)lds + RING_OFF + 65536);
        const int r32 = lane & 31, hi = lane >> 5;
        const int cc = (tid & 31) * 8, q0 = tid >> 5;
        for (int ck = vcu; ck < T / 128; ck += G) {
            const size_t m0 = (size_t)ck * 128;
            v4u vr[8], ur[8];
            char* zc = (char*)(Z + m0 * 4096);
            const unsigned toff = (unsigned)(q0 * 4096 + cc) * 2u;
#define ZT(i, colb) (*(v4u*)(zc + (size_t)((i) * 16 * 4096 * 2 + (colb)) + toff))
#pragma unroll
            for (int i = 0; i < 8; ++i) vr[i] = ZT(i, 4096);
            for (int i0 = 0; i0 < 16; i0 += 4) {
                v4u wq[4][4];
#pragma unroll
                for (int u = 0; u < 4; ++u) { const bf16* vrow = Z + (m0 + wave * 16 + i0 + u) * 4096 + 2048;
#pragma unroll
                    for (int j = 0; j < 4; ++j) wq[u][j] = *(const v4u*)(vrow + j * 512 + lane * 8); }
#pragma unroll
                for (int u = 0; u < 4; ++u) { const int q = wave * 16 + i0 + u;
                    float xv[32]; float s = 0.f;
#pragma unroll
                    for (int j = 0; j < 4; ++j) {
#pragma unroll
                        for (int k = 0; k < 4; ++k) { xv[j * 8 + 2 * k] = att::bf_lo(wq[u][j][k]); xv[j * 8 + 2 * k + 1] = att::bf_hi(wq[u][j][k]); } }
#pragma unroll
                    for (int k = 0; k < 32; ++k) s += xv[k];
                    const float mean = wave_sum(s) * (1.0f / 2048.0f); float s2 = 0.f;
#pragma unroll
                    for (int k = 0; k < 32; ++k) { const float d = xv[k] - mean; s2 += d * d; }
                    const float rstd = rsqrtf(wave_sum(s2) * (1.0f / 2048.0f) + EPS);
                    if (lane == 0) { stat[q] = mean; stat[128 + q] = rstd; } } }
            __syncthreads();
            const int pw = (wave & 3) * 32, chf = wave >> 2;
            for (int gI = 0; gI < 8; ++gI) {
                { const int cg = gI * 256 + cc;
                  const f32x4 w0 = *(const f32x4*)(vnw + cg), w1 = *(const f32x4*)(vnw + cg + 4), b0 = *(const f32x4*)(vnb + cg), b1 = *(const f32x4*)(vnb + cg + 4);
#pragma unroll
                  for (int i = 0; i < 8; ++i) { const int q = q0 + 16 * i; const v4u w = vr[i]; const float mean = stat[q], rstd = stat[128 + q];
                      float xv[8];
#pragma unroll
                      for (int k = 0; k < 4; ++k) { xv[2 * k] = att::bf_lo(w[k]); xv[2 * k + 1] = att::bf_hi(w[k]); }
                      v4u o; o.x = pk2((xv[0] - mean) * rstd * w0[0] + b0[0], (xv[1] - mean) * rstd * w0[1] + b0[1]); o.y = pk2((xv[2] - mean) * rstd * w0[2] + b0[2], (xv[3] - mean) * rstd * w0[3] + b0[3]);
                      o.z = pk2((xv[4] - mean) * rstd * w1[0] + b1[0], (xv[5] - mean) * rstd * w1[1] + b1[1]); o.w = pk2((xv[6] - mean) * rstd * w1[2] + b1[2], (xv[7] - mean) * rstd * w1[3] + b1[3]);
                      *(v4u*)(Vl + ((q >> 6) * 2 + (cc >> 7)) * 16384 + att::v_st(q & 63, cc & 127)) = o; } }
                bf16x8 wa[8];
#pragma unroll
                for (int ks = 0; ks < 8; ++ks) wa[ks] = *(const bf16x8*)(WSB + ((size_t)gI * 128 + pw + r32) * 128 + ks * 16 + hi * 8);
                __syncthreads();
                if (gI < 7) {
#pragma unroll
                    for (int i = 0; i < 8; ++i) vr[i] = ZT(i, 4096 + (gI + 1) * 512); }
#pragma unroll
                for (int i = 0; i < 8; ++i) ur[i] = ZT(i, gI * 512);
                f32x16 o[4];
#pragma unroll
                for (int d = 0; d < 4; ++d) o[d] = f32x16{};
                const int vb = (int)(uintptr_t)(Vl + chf * 16384) + att::v_rd_base(lane);
                att::pv_d0(o, vb, wa[0], wa[1], wa[2], wa[3]);
                att::pv_d0(o, vb + 32768, wa[4], wa[5], wa[6], wa[7]);
#pragma unroll
                for (int r = 0; r < 16; ++r) { const int p = pw + att::crow(r, hi); const float bsv = bs[gI * 128 + p]; bf16* sp = Sl + p * 256 + chf * 128 + r32;
#pragma unroll
                    for (int d0 = 0; d0 < 4; ++d0) sp[32 * d0] = (bf16)pk2(o[d0][r] + bsv, 0.f); }
                __syncthreads();
#pragma unroll
                for (int i = 0; i < 8; ++i) { const int q = q0 + 16 * i; const v4u sv = *(const v4u*)(Sl + q * 256 + cc); const v4u uv = ur[i]; v4u ov;
#pragma unroll
                    for (int k = 0; k < 4; ++k) ov[k] = pk2(att::bf_lo(uv[k]) * att::bf_lo(sv[k]), att::bf_hi(uv[k]) * att::bf_hi(sv[k]));
                    ZT(i, gI * 512) = ov; }
            }
#undef ZT
            __syncthreads();
        }
        GRID_BAR();
    }
    if (IN(11)) { PHASE_BEGIN();
        pg8::Gemm g{(const bf16*)(ws + WS_Z), (const bf16*)(ws + WS_WOUT), 4096, GMH, GMH}; pg8::StaticOrder S; S.init(128, 4, G, bx);
        pg8::EpiRes E{xres, xres, MODP(1, 0, 2), 6144};
        pg8::gemm_phase(ldsl + RING_OFF, g, S, E);
        GRID_BAR();
    }
    int* TOKE = (int*)(ws + WS_TOKE); float* TOKG = (float*)(ws + WS_TOKG); int* CNT = (int*)(ws + WS_CNT);
    int* PANE = (int*)(ws + WS_PANE); int* PANV = (int*)(ws + WS_PANV); int* NPAN = (int*)(ws + WS_NPAN);
    int* TSLOT = (int*)(ws + WS_TSLOT);
    constexpr int TPW = T / 256;
    if (IN(12)) { PHASE_BEGIN();
        LAS int* lcnt = (LAS int*)(ldsl + RING_OFF);
        if (tid < 16) lcnt[tid] = 0;
        __syncthreads();
        const RowVec wn = load_vec(norm2_w + DM, lane);
        const float* wr_ = args.in[25];
        f32x4 wra[16], wrb[16];
#pragma unroll
        for (int j = 0; j < 4; ++j)
#pragma unroll
            for (int k = 0; k < 4; ++k) { const float* wp = wr_ + (size_t)(256 * j + 4 * lane + k) * 8; wra[4 * j + k] = *(const f32x4*)wp; wrb[4 * j + k] = *(const f32x4*)(wp + 4); }
        for (int ch = vcu; ch < T / TPW; ch += G) {
            const int b = (ch * TPW) >> 14;
            const RowVec sh = load_vec(MODP(1, b, 3), lane), sc = load_vec(MODP(1, b, 4), lane);
            for (int i0 = wave; i0 < TPW; i0 += 2 * NWAVES) {
                RowVec yy[2];
#pragma unroll
                for (int u = 0; u < 2; ++u) yy[u] = load_vec(xres + ((size_t)ch * TPW + i0 + u * NWAVES) * DM, lane);
#pragma unroll
                for (int u = 0; u < 2; ++u) { const size_t row = (size_t)ch * TPW + i0 + u * NWAVES; RowVec& y = yy[u]; float ssq = 0.f;
#pragma unroll
                    for (int j = 0; j < 4; ++j) ssq += (y.v[j].x * y.v[j].x + y.v[j].y * y.v[j].y) + (y.v[j].z * y.v[j].z + y.v[j].w * y.v[j].w);
                    const float rs = rsqrtf(wave_sum(ssq) * (1.0f / DM) + EPS);
#pragma unroll
                    for (int j = 0; j < 4; ++j) y.v[j] = y.v[j] * rs * wn.v[j] * (1.0f + sc.v[j]) + sh.v[j];
                    { LAS f32x4* st = (LAS f32x4*)(ldsl + RING_OFF + 1024 + wave * 9216 + (u * 32 + (lane >> 3)) * 144 + (lane & 7) * 16);
#pragma unroll
                      for (int j = 0; j < 4; ++j) st[j * 8 * 9] = y.v[j]; }
                    float lg[8];
#pragma unroll
                    for (int e = 0; e < 8; ++e) lg[e] = 0.f;
#pragma unroll
                    for (int j = 0; j < 4; ++j)
#pragma unroll
                        for (int k = 0; k < 4; ++k) { const f32x4 wa = wra[4 * j + k], wb = wrb[4 * j + k]; const float yv = y.v[j][k];
                            lg[0] += yv * wa[0]; lg[1] += yv * wa[1]; lg[2] += yv * wa[2]; lg[3] += yv * wa[3]; lg[4] += yv * wb[0]; lg[5] += yv * wb[1]; lg[6] += yv * wb[2]; lg[7] += yv * wb[3]; }
#pragma unroll
                    for (int e = 0; e < 8; ++e) lg[e] = wave_sum(lg[e]);
                    int e1 = 0; float v1 = lg[0];
#pragma unroll
                    for (int e = 1; e < 8; ++e) if (lg[e] > v1) { v1 = lg[e]; e1 = e; }
                    int e2 = -1; float v2 = -INFINITY;
#pragma unroll
                    for (int e = 0; e < 8; ++e) if (e != e1 && lg[e] > v2) { v2 = lg[e]; e2 = e; }
                    const float ex = __expf(v2 - v1), g1v = 1.0f / (1.0f + ex), g2v = ex * g1v;
                    if (lane == 0) { TOKE[row * 2] = e1; TOKE[row * 2 + 1] = e2; TOKG[row * 2] = g1v; TOKG[row * 2 + 1] = g2v; atomicAdd((int*)&lcnt[e1], 1); atomicAdd((int*)&lcnt[8 + e2], 1); }
                }
                { LDS_WAIT(); asm volatile("" ::: "memory");
                  const int u = lane >> 5, blk = lane & 31; const LAS f32x4* sp = (const LAS f32x4*)(ldsl + RING_OFF + 1024 + wave * 9216 + (u * 32 + blk) * 144);
                  pg8::v16f32 x, y; float mx = 0.f;
#pragma unroll
                  for (int q = 0; q < 4; ++q) { const f32x4 a = sp[q], b2 = sp[4 + q];
#pragma unroll
                      for (int k = 0; k < 4; ++k) { x[4 * q + k] = a[k]; y[4 * q + k] = b2[k]; mx = fmaxf(mx, fmaxf(fabsf(a[k]), fabsf(b2[k]))); } }
                  const pg8::v8i32 c8 = pg8::fp6_chunk(x, y, mx);
                  unsigned char* dst = (unsigned char*)(ws + WS_H8) + ((size_t)ch * TPW + i0 + u * NWAVES) * DM + (blk >> 2) * 128 + (blk & 3) * 16;
                  *(v4u*)dst = (v4u){(unsigned)c8[0], (unsigned)c8[1], (unsigned)c8[2], (unsigned)c8[3]};
                  *(v4u*)(dst + 64) = (v4u){(unsigned)c8[4], (unsigned)c8[5], (unsigned)c8[6], (unsigned)c8[7]};
                  LDS_WAIT(); asm volatile("" ::: "memory"); }
            }
            __syncthreads();
            if (tid < 16) { CNT[ch * 16 + tid] = lcnt[tid]; lcnt[tid] = 0; }
            __syncthreads();
        }
        GRID_BAR();
    }
    if (IN(13)) { PHASE_BEGIN();
        LAS int* sb = (LAS int*)(ldsl + RING_OFF);
        for (int ch = vcu; ch < T / TPW; ch += G) {
            if (wave == 0) {
                const int ke = lane & 15, qt = lane >> 4; int tot = 0, pre = 0;
                for (int c0 = qt * 64; c0 < qt * 64 + 64; c0 += 16) { int cv[16];
#pragma unroll
                    for (int u = 0; u < 16; ++u) cv[u] = CNT[(c0 + u) * 16 + ke];
#pragma unroll
                    for (int u = 0; u < 16; ++u) { tot += cv[u]; pre += (c0 + u < ch) ? cv[u] : 0; } }
                tot += __shfl_xor(tot, 16); tot += __shfl_xor(tot, 32); pre += __shfl_xor(pre, 16); pre += __shfl_xor(pre, 32);
                const int pad = (tot + 255) & ~255; int scan = 0;
#pragma unroll
                for (int e = 0; e < 8; ++e) { const int pe = __shfl(pad, (ke & 8) + e); scan += (e < (ke & 7)) ? pe : 0; }
                int reg0 = 0;
#pragma unroll
                for (int e = 0; e < 8; ++e) reg0 += __shfl(pad, e);
                const int rb = (ke >> 3) ? reg0 : 0;
                if (lane < 16) { sb[ke] = rb + scan + pre; sb[16 + ke] = tot; sb[32 + ke] = (rb + scan) >> 8; }
            }
            __syncthreads();
            if (ch == 0 && wave == 1) {
                for (int p = lane; p < MAX_PANELS; p += 64) { int ex = -1;
#pragma unroll
                    for (int ke = 0; ke < 16; ++ke) { const int pb = sb[32 + ke], np = (sb[16 + ke] + 255) >> 8; if (p >= pb && p < pb + np) ex = ke & 7; }
                    PANE[p] = ex; }
                if (lane == 0) NPAN[0] = sb[32 + 15] + ((sb[16 + 15] + 255) >> 8);
            }
            if (wave == 0) {
#pragma unroll
                for (int k = 0; k < 2; ++k) {
                    int run[8];
#pragma unroll
                    for (int e = 0; e < 8; ++e) run[e] = 0;
#pragma unroll
                    for (int half = 0; half < 2; ++half) { const int tok = ch * TPW + half * 64 + lane; const int e = TOKE[tok * 2 + k]; int rank = 0, base = 0;
#pragma unroll
                        for (int ee = 0; ee < 8; ++ee) { const unsigned long long mk = __ballot(e == ee); if (e == ee) { rank = run[ee] + __popcll(mk & ((1ull << lane) - 1ull)); base = sb[k * 8 + ee]; } run[ee] += __popcll(mk); }
                        const int slot = base + rank; TSLOT[tok * 2 + k] = slot;
                        ((LAS int*)(ldsl + RING_OFF + 1024))[k * 128 + half * 64 + lane] = slot; }
                }
            }
            __syncthreads();
            const LAS int* sl = (const LAS int*)(ldsl + RING_OFF + 1024);
            for (int i0 = wave; i0 < 2 * TPW; i0 += 8 * NWAVES) {
                v4u rowv[8]; int slot8[8];
#pragma unroll
                for (int u = 0; u < 8; ++u) { const int i = i0 + u * NWAVES, k = i >> 7, tl = i & 127; slot8[u] = sl[k * 128 + tl];
                    rowv[u] = ((const v4u*)((const unsigned char*)(ws + WS_H8) + ((size_t)ch * TPW + tl) * DM))[lane]; }
#pragma unroll
                for (int u = 0; u < 8; ++u) ((v4u*)((unsigned char*)(ws + WS_AP8) + (size_t)slot8[u] * DM))[lane] = rowv[u]; }
            __syncthreads();
        }
        GRID_BAR();
    }
#define MOE_PASS(PASS) int rS = NPAN[0] - 4 * PASS_PANELS; rS = rS < 0 ? 0 : (rS > PASS_PANELS ? PASS_PANELS : rS); const int p0 = (PASS) == 0 ? 0 : rS + ((PASS) - 1) * PASS_PANELS; \
        int nM = (PASS) == 0 ? rS : NPAN[0] - p0; nM = nM < 0 ? 0 : (nM > PASS_PANELS ? PASS_PANELS : nM);
#define MOE_GU(PASS) do { MOE_PASS(PASS) \
        pg8::Gemm g{(const bf16*)(ws + WS_AP8), (const bf16*)(ws + WS_MGU), DM / 2, DM / 2, DM / 2}; pg8::MoeOrder S; S.init(nM, 28, G, bx, p0, PANE, true, (PASS) == 1 ? rS * 4 : 0, 4); \
        pg8::EpiSwiGLUT<true> E{(bf16*)(ws + WS_HM + ((PASS) & 1) * HM_BYTES), EXD, p0, 1.0f, H8SCALE}; \
        pg8::gemm_phase<pg8::EpiSwiGLUT<true>, pg8::MoeOrder, 2>(ldsl + RING_OFF, g, S, E); } while (0)
#define MOE_DN(PASS) do { MOE_PASS(PASS) \
        pg8::Gemm g{(const bf16*)(ws + WS_HM + ((PASS) & 1) * HM_BYTES), (const bf16*)(ws + WS_MD), EXD / 2, EXD / 2, EXD / 2}; pg8::MoeOrder S; S.init(nM, 4, G, bx, p0, PANE, false); \
        pg8::EpiStore E{(bf16*)(ws + WS_Y), DM, p0, 1.0f / (W8SCALE * H8SCALE)}; \
        pg8::gemm_phase<pg8::EpiStore, pg8::MoeOrder, 1>(ldsl + RING_OFF, g, S, E); } while (0)
    if (IN(14)) { PHASE_BEGIN(); MOE_GU(0); GRID_BAR(); }
    if (IN(15)) { PHASE_BEGIN(); MOE_DN(0); MOE_GU(1); GRID_BAR(); }
    if (IN(16)) { PHASE_BEGIN(); MOE_DN(1); MOE_GU(2); GRID_BAR(); }
    if (IN(17)) { PHASE_BEGIN(); MOE_DN(2); MOE_GU(3); GRID_BAR(); }
    if (IN(18)) { PHASE_BEGIN(); MOE_DN(3); MOE_GU(4); GRID_BAR(); }
    if (IN(19)) { PHASE_BEGIN(); MOE_DN(4); GRID_BAR(); }
    if (IN(24)) { PHASE_BEGIN();
        const RowVec wn = load_vec(final_w, lane); const bf16* Y = (const bf16*)(ws + WS_Y);
        for (int b = 0; b < 2; ++b) {
            const RowVec g2 = load_vec(MODP(1, b, 5), lane);
            for (int m = gw; m < SEQ; m += 2 * NGW) {
                size_t rowu[2]; RowVec xu[2]; unsigned long long ya[2][4], yb[2][4]; float gau[2], gbu[2];
#pragma unroll
                for (int u = 0; u < 2; ++u) { rowu[u] = (size_t)b * SEQ + m + u * NGW;
                    const int s1 = TSLOT[rowu[u] * 2], s2 = TSLOT[rowu[u] * 2 + 1]; gau[u] = TOKG[rowu[u] * 2]; gbu[u] = TOKG[rowu[u] * 2 + 1];
                    const unsigned long long* y1 = (const unsigned long long*)(Y + (size_t)s1 * DM) + lane; const unsigned long long* y2 = (const unsigned long long*)(Y + (size_t)s2 * DM) + lane;
                    xu[u] = load_vec(xres + rowu[u] * DM, lane);
#pragma unroll
                    for (int j = 0; j < 4; ++j) { ya[u][j] = y1[64 * j]; yb[u][j] = y2[64 * j]; } }
#pragma unroll
                for (int u = 0; u < 2; ++u) { float ssq = 0.f; const float ga = gau[u], gb = gbu[u];
#pragma unroll
                    for (int j = 0; j < 4; ++j) { const unsigned long long a = ya[u][j], c = yb[u][j]; const unsigned a0 = (unsigned)a, a1 = (unsigned)(a >> 32), c0 = (unsigned)c, c1 = (unsigned)(c >> 32);
                        f32x4 yv; yv.x = ga * att::bf_lo(a0) + gb * att::bf_lo(c0); yv.y = ga * att::bf_hi(a0) + gb * att::bf_hi(c0); yv.z = ga * att::bf_lo(a1) + gb * att::bf_lo(c1); yv.w = ga * att::bf_hi(a1) + gb * att::bf_hi(c1);
                        xu[u].v[j] = xu[u].v[j] + g2.v[j] * yv; ssq += (xu[u].v[j].x * xu[u].v[j].x + xu[u].v[j].y * xu[u].v[j].y) + (xu[u].v[j].z * xu[u].v[j].z + xu[u].v[j].w * xu[u].v[j].w); }
                    const float rs = rsqrtf(wave_sum(ssq) * (1.0f / DM) + EPS); f32x4* o = (f32x4*)(xres + rowu[u] * DM) + lane;
#pragma unroll
                    for (int j = 0; j < 4; ++j) o[64 * j] = xu[u].v[j] * rs * wn.v[j]; } }
        }
    }
#undef IN
#undef GRID_BAR
}

extern "C" void kernel_launch(void* const* d_in, const int* in_sizes, int n_in, void* d_out, int out_size, void* d_ws, size_t ws_size, hipStream_t stream) {
    static int grid = 0;
    if (grid == 0) {
        if (n_in != 29 || in_sizes[0] != T * DM || out_size != T * DM || ws_size < WS_END) { fprintf(stderr, "kernel_launch: shape/workspace mismatch (n_in %d, in0 %d, out %d, ws %zu, need %zu)\n", n_in, n_in > 0 ? in_sizes[0] : -1, out_size, ws_size, (size_t)WS_END); grid = -1; return; }
        int dev = 0, cus = 0;
        if (hipGetDevice(&dev) != hipSuccess || hipDeviceGetAttribute(&cus, hipDeviceAttributeMultiprocessorCount, dev) != hipSuccess) { grid = -1; return; }
        if (hipFuncSetAttribute((const void*)fwd_kernel, hipFuncAttributeMaxDynamicSharedMemorySize, LDS_BYTES) != hipSuccess) { fprintf(stderr, "kernel_launch: hipFuncSetAttribute failed\n"); grid = -1; return; }
        int per_cu = 0;
        if (hipOccupancyMaxActiveBlocksPerMultiprocessor(&per_cu, (const void*)fwd_kernel, NWAVES * 64, LDS_BYTES) != hipSuccess || per_cu < 1) fprintf(stderr, "kernel_launch: occupancy query reports %d\n", per_cu);
        (void)hipGetLastError();
        grid = cus;
        if (grid != 256) fprintf(stderr, "kernel_launch: %d CUs (built for 256)\n", grid);
    }
    if (grid < 0) return;
    if (hipMemsetAsync((char*)d_ws + WS_CTL, 0, CTL_ZERO_BYTES, stream) != hipSuccess) return;
    Args a{};
    for (int i = 0; i < 29; ++i) a.in[i] = (const float*)d_in[i];
    a.out = (float*)d_out; a.ws = (unsigned char*)d_ws;
#if MK_N_LAUNCHES == 1
    a.ph_lo = 0; a.ph_hi = N_PHASES;
    hipLaunchKernelGGL(fwd_kernel, dim3(grid), dim3(NWAVES * 64), LDS_BYTES, stream, a);
#else
#ifndef PROBE_SEQ
#define PROBE_SEQ 0,1,2,3,4,5,6,7,8,9,10,11,12,13,14,15,16,17,18,19,20,21,22,23,24
#endif
    { const int seq[] = {PROBE_SEQ}; for (int p : seq) { a.ph_lo = p; a.ph_hi = p + 1; hipLaunchKernelGGL(fwd_kernel, dim3(grid), dim3(NWAVES * 64), LDS_BYTES, stream, a); } }
#endif
    const hipError_t le = hipPeekAtLastError();
    if (le != hipSuccess) fprintf(stderr, "kernel_launch: launch failed: %s\n", hipGetErrorName(le));
}
```

```cpp
#include <hip/hip_runtime.h>
#include <hip/hip_bf16.h>
#include <cstdio>
#include <cstdint>
#include <cmath>

#ifndef MK_N_LAUNCHES
#define MK_N_LAUNCHES 1
#endif

constexpr int BATCH = 2, SEQ = 16384, DM = 1024, T = BATCH * SEQ, CTXL = 256, SK = CTXL + SEQ;
constexpr int NH = 8, FFN = 2816, GMH = 2048, NE = 8, EXD = 3584;
constexpr bool QKV_F8 = true;
constexpr float EPS = 1e-6f;
constexpr float LAM_INIT = 0.2f;
constexpr float H8SCALE = 2.0f;
constexpr float W8SCALE = 64.0f;
constexpr float QSCALE = 0.125f * 1.4426950408889634f;

namespace pg8 {
#define PG8_LAS __attribute__((address_space(3)))
typedef unsigned short bf16_t;
typedef short bf16x8 __attribute__((ext_vector_type(8)));
typedef float f32x4 __attribute__((ext_vector_type(4)));
typedef float f32x2 __attribute__((ext_vector_type(2)));
typedef unsigned u32x4 __attribute__((ext_vector_type(4)));
constexpr int BM = 256, BK = 64, HALF = 128, HTB = HALF * BK * 2, STAGE_BYTES = 8 * HTB, NXCD = 8, WGM = 8;

__host__ __device__ __forceinline__ int lds_byte(int r, int c) { const int st = (r >> 4) * 2 + (c >> 5), rr = r & 15, cc = c & 31, ob = rr * 64 + cc * 2; return st * 1024 + (ob ^ (((ob >> 9) & 1) << 5)); }
__host__ __device__ __forceinline__ void stage_rc(int b, int& R, int& C) { const int st = b / 1024, sb = b % 1024, swz = sb ^ (((sb >> 9) & 1) << 5); R = (st >> 1) * 16 + swz / 64; C = (st & 1) * 32 + (swz % 64) / 2; }
__host__ __device__ __forceinline__ int perm32(int rho) { const int n = rho >> 4, i = rho & 15; return 8 * (i >> 2) + 4 * n + (i & 3); }

struct Unit { int pm, pn, pb; };
struct Gemm { const bf16_t* A; const bf16_t* Bt; int lda, ldb, K; };

__device__ __forceinline__ void map_unit(int wgid, int nM, int nN, int& pm, int& pn) {
    const int nwg = nM * nN;
    { const int q = nwg / NXCD, r = nwg % NXCD, xcd = wgid % NXCD, off = wgid / NXCD; wgid = (xcd < r ? xcd * (q + 1) : r * (q + 1) + (xcd - r) * q) + off; }
    const int nig = WGM * nN, gid = wgid / nig, fm = gid * WGM, gsz = (nM - fm) < WGM ? (nM - fm) : WGM;
    pm = fm + ((wgid % nig) % gsz); pn = (wgid % nig) / gsz;
}
struct StaticOrder {
    int nM, nN, nwg, G, c;
    __device__ __forceinline__ void init(int nM_, int nN_, int G_, int c_) { nM = nM_; nN = nN_; nwg = nM * nN; G = G_; c = c_; }
    __device__ __forceinline__ bool next(int i, Unit& u) const {
        const long L = (long)i * G + c; if (L >= nwg) return false;
        map_unit((int)L, nM, nN, u.pm, u.pn); u.pb = u.pn; return true;
    }
};
struct MoeOrder {
    int nM, nN, nwg, G, c, p0, nBusy, skipR; const int* panel_e; bool keepGlobal;
    __device__ __forceinline__ void init(int nM_, int nN_, int G_, int c_, int p0_, const int* pe, bool kg, int nBusy_ = 0, int skipR_ = 0) { nM = nM_; nN = nN_; nwg = nM * nN; G = G_; c = c_; p0 = p0_; panel_e = pe; keepGlobal = kg; nBusy = nBusy_; skipR = nBusy_ > 0 ? skipR_ : 0; }
    __device__ __forceinline__ bool next(int i, Unit& u) const {
        long L;
        if (skipR == 0) L = (long)i * G + c;
        else { const int Gp = G - nBusy;
            if (c >= nBusy) L = i < skipR ? (long)i * Gp + (c - nBusy) : (long)skipR * Gp + (long)(i - skipR) * G + c;
            else L = (long)skipR * Gp + (long)i * G + c; }
        if (L >= nwg) return false;
        int pm, pn; map_unit((int)L, nM, nN, pm, pn);
        const int e = __builtin_amdgcn_readfirstlane(panel_e[p0 + pm]);
        u.pm = keepGlobal ? p0 + pm : pm; u.pn = pn; u.pb = e * nN + pn; return true;
    }
};

__device__ __forceinline__ unsigned cvt_pk_bf16(float lo, float hi) { unsigned r; asm volatile("v_cvt_pk_bf16_f32 %0, %1, %2" : "=v"(r) : "v"(lo), "v"(hi)); return r; }
__device__ __forceinline__ f32x2 gelu_pk(f32x2 v) {
    const f32x2 av = __builtin_elementwise_abs(v);
    f32x2 p = av * 5.62129966396221e-06f + 5.105520900865985e-05f; p = p * av + 3.968613701101391e-05f; p = p * av + 0.003422739238900825f; p = p * av + 0.022076998456581717f;
    p = p * av + 0.052075163036630574f; p = p * av + 1.0442737824274138f;
    p = p * p; p = p * p; p = p * p; p = p * p;
    f32x2 h; h.x = __builtin_amdgcn_rcpf(p.x); h.y = __builtin_amdgcn_rcpf(p.y);
    const f32x2 m = v * h, r = v - m;
    f32x2 o; o.x = v.x < 0.f ? m.x : r.x; o.y = v.y < 0.f ? m.y : r.y; return o;
}
__device__ __forceinline__ float silu_f(float g) { return g * __builtin_amdgcn_rcpf(1.0f + __builtin_amdgcn_exp2f(-1.4426950408889634f * g)); }

struct EpiQKV {
    static constexpr bool PERM = true;
    bf16_t *Q, *K, *V; const float* cs; const float* sn; float wsc;
    __device__ __forceinline__ void operator()(const f32x4 (&acc)[2][2][4][2], const Unit& u, int wr, int wc, int fr, int fq) const {
        const int sect = u.pn >> 2, cin = (u.pn & 3) * 256; const bool isctx = u.pm >= 128;
        if (isctx && sect == 0) return;
        int b, t0; if (!isctx) { b = u.pm >> 6; t0 = (u.pm & 63) * 256; } else { b = u.pm - 128; t0 = 0; }
        bf16_t* base; size_t rowbase;
        if (sect == 0) { base = Q; rowbase = (size_t)u.pm * 256; } else { base = sect == 1 ? K : V; rowbase = (size_t)b * SK + (isctx ? 0 : CTXL + t0); }
        const bool rope = (sect < 2) && !isctx; const float sc = (sect == 0 ? QSCALE : 1.0f) * wsc;
        const int col0 = cin + wc * 32 + 8 * fq, axis = wc & 1;
#pragma unroll
        for (int ai = 0; ai < 2; ++ai)
#pragma unroll
            for (int m = 0; m < 4; ++m) {
                const int r = wr * 64 + ai * HALF + m * 16 + fr, t = t0 + r;
                f32x4 c4 = (f32x4){1.f, 1.f, 1.f, 1.f}, s4 = (f32x4){0.f, 0.f, 0.f, 0.f};
                if (rope) { const int pos = axis ? (t & 63) : (t >> 6); c4 = *(const f32x4*)(cs + pos * 16 + 4 * fq); s4 = *(const f32x4*)(sn + pos * 16 + 4 * fq); }
                bf16_t* rowp = base + (rowbase + r) * DM + col0;
#pragma unroll
                for (int bj = 0; bj < 2; ++bj) {
                    const f32x4 v0 = acc[ai][bj][m][0], v1 = acc[ai][bj][m][1];
                    const f32x4 o0 = (v0 * c4 - v1 * s4) * sc, o1 = (v0 * s4 + v1 * c4) * sc;
                    u32x4 w; w.x = cvt_pk_bf16(o0[0], o0[1]); w.y = cvt_pk_bf16(o0[2], o0[3]); w.z = cvt_pk_bf16(o1[0], o1[1]); w.w = cvt_pk_bf16(o1[2], o1[3]);
                    *(u32x4*)(rowp + bj * HALF) = w; }
            }
    }
};
struct EpiRes {
    static constexpr bool PERM = false;
    const float* xin; float* out; const float* gate;
    int gstride;
    __device__ __forceinline__ void operator()(const f32x4 (&acc)[2][2][4][2], const Unit& u, int wr, int wc, int fr, int fq) const {
        const int b = u.pm >> 6, col0 = u.pn * BM + wc * 32 + 4 * fq; const float* g = gate + (size_t)b * gstride + col0;
        f32x4 gv[2][2];
#pragma unroll
        for (int bj = 0; bj < 2; ++bj)
#pragma unroll
            for (int n = 0; n < 2; ++n) gv[bj][n] = *(const f32x4*)(g + bj * HALF + n * 16);
#pragma unroll
        for (int ai = 0; ai < 2; ++ai)
#pragma unroll
            for (int m = 0; m < 4; ++m) { const size_t off = (size_t)(u.pm * BM + ai * HALF + wr * 64 + m * 16 + fr) * DM + col0;
#pragma unroll
                for (int bj = 0; bj < 2; ++bj)
#pragma unroll
                    for (int n = 0; n < 2; ++n) { const f32x4 xi = *(const f32x4*)(xin + off + bj * HALF + n * 16); *(f32x4*)(out + off + bj * HALF + n * 16) = xi + gv[bj][n] * acc[ai][bj][m][n]; }
                if (m & 1) asm volatile("" ::: "memory"); }
    }
};
template <bool OUT8> struct EpiSwiGLUT {
    static constexpr bool PERM = true;
    bf16_t* H; int ldh, pm0; float sc; float osc;
    __device__ __forceinline__ void operator()(const f32x4 (&acc)[2][2][4][2], const Unit& u, int wr, int wc, int fr, int fq) const {
        const int col0 = u.pn * HALF + wc * 32 + 8 * fq;
#pragma unroll
        for (int ai = 0; ai < 2; ++ai)
#pragma unroll
            for (int m = 0; m < 4; ++m) { bf16_t* rowp = H + (size_t)((u.pm - pm0) * BM + wr * 64 + ai * HALF + m * 16 + fr) * ldh + col0;
                const f32x4 g0 = acc[ai][0][m][0] * sc, g1 = acc[ai][0][m][1] * sc, u0 = acc[ai][1][m][0] * sc, u1 = acc[ai][1][m][1] * sc;
                f32x4 h0, h1;
#pragma unroll
                for (int j = 0; j < 4; ++j) { h0[j] = silu_f(g0[j]) * u0[j]; h1[j] = silu_f(g1[j]) * u1[j]; }
                if constexpr (OUT8) { unsigned char* rp8 = (unsigned char*)H + (size_t)((u.pm - pm0) * BM + wr * 64 + ai * HALF + m * 16 + fr) * ldh + col0;
                    int w0 = __builtin_amdgcn_cvt_pk_fp8_f32(h0[0] * osc, h0[1] * osc, 0, false); w0 = __builtin_amdgcn_cvt_pk_fp8_f32(h0[2] * osc, h0[3] * osc, w0, true);
                    int w1 = __builtin_amdgcn_cvt_pk_fp8_f32(h1[0] * osc, h1[1] * osc, 0, false); w1 = __builtin_amdgcn_cvt_pk_fp8_f32(h1[2] * osc, h1[3] * osc, w1, true);
                    *(unsigned long long*)rp8 = (unsigned long long)(unsigned)w0 | ((unsigned long long)(unsigned)w1 << 32); }
                else { u32x4 w; w.x = cvt_pk_bf16(h0[0], h0[1]); w.y = cvt_pk_bf16(h0[2], h0[3]); w.z = cvt_pk_bf16(h1[0], h1[1]); w.w = cvt_pk_bf16(h1[2], h1[3]);
                    *(u32x4*)rowp = w; } }
    }
};
typedef EpiSwiGLUT<false> EpiSwiGLU;
struct EpiGelu {
    static constexpr bool PERM = true;
    bf16_t* O; int ldc;
    __device__ __forceinline__ void operator()(const f32x4 (&acc)[2][2][4][2], const Unit& u, int wr, int wc, int fr, int fq) const {
        const int col0 = u.pn * BM + wc * 32 + 8 * fq;
#pragma unroll
        for (int ai = 0; ai < 2; ++ai)
#pragma unroll
            for (int m = 0; m < 4; ++m) { bf16_t* rowp = O + (size_t)(u.pm * BM + wr * 64 + ai * HALF + m * 16 + fr) * ldc + col0;
#pragma unroll
                for (int bj = 0; bj < 2; ++bj) { const f32x4 v0 = acc[ai][bj][m][0], v1 = acc[ai][bj][m][1];
                    const f32x2 a = gelu_pk((f32x2){v0[0], v0[1]}), b = gelu_pk((f32x2){v0[2], v0[3]}), c = gelu_pk((f32x2){v1[0], v1[1]}), d = gelu_pk((f32x2){v1[2], v1[3]});
                    u32x4 w; w.x = cvt_pk_bf16(a.x, a.y); w.y = cvt_pk_bf16(b.x, b.y); w.z = cvt_pk_bf16(c.x, c.y); w.w = cvt_pk_bf16(d.x, d.y);
                    *(u32x4*)(rowp + bj * HALF) = w; } }
    }
};
struct EpiStore {
    static constexpr bool PERM = true;
    bf16_t* O; int ldc, pm0; float sc;
    __device__ __forceinline__ void operator()(const f32x4 (&acc)[2][2][4][2], const Unit& u, int wr, int wc, int fr, int fq) const {
        const int col0 = u.pn * BM + wc * 32 + 8 * fq;
#pragma unroll
        for (int ai = 0; ai < 2; ++ai)
#pragma unroll
            for (int m = 0; m < 4; ++m) { bf16_t* rowp = O + (size_t)((u.pm + pm0) * BM + wr * 64 + ai * HALF + m * 16 + fr) * ldc + col0;
#pragma unroll
                for (int bj = 0; bj < 2; ++bj) { const f32x4 v0 = acc[ai][bj][m][0] * sc, v1 = acc[ai][bj][m][1] * sc;
                    u32x4 w; w.x = cvt_pk_bf16(v0[0], v0[1]); w.y = cvt_pk_bf16(v0[2], v0[3]); w.z = cvt_pk_bf16(v1[0], v1[1]); w.w = cvt_pk_bf16(v1[2], v1[3]);
                    *(u32x4*)(rowp + bj * HALF) = w; } }
    }
};

typedef int v8i32 __attribute__((ext_vector_type(8)));
typedef int v4i32 __attribute__((ext_vector_type(4)));
typedef int v6i32 __attribute__((ext_vector_type(6)));
typedef float v16f32 __attribute__((ext_vector_type(16)));
__device__ __forceinline__ v6i32 lo6(v8i32 x) { return __builtin_shufflevector(x, x, 0, 1, 2, 3, 4, 5); }
__device__ __forceinline__ v8i32 fp6_chunk(v16f32 x, v16f32 y, float mx) {
    int e = __builtin_amdgcn_frexp_expf(mx * 1.0666667f) - 3;
    e = e < -100 ? -100 : e;
    const float inv = __int_as_float((127 - e) << 23);
    const v6i32 q = __builtin_amdgcn_cvt_scalef32_2xpk16_fp6_f32(x * inv, y * inv, 1.0f);
    const int sw = ((e + 127) & 0xff) * 0x01010101;
    return (v8i32){q[0], q[1], q[2], q[3], q[4], q[5], sw, 0};
}
__device__ __forceinline__ v8i32 cat32(bf16x8 a, bf16x8 b) { const v4i32 x = __builtin_bit_cast(v4i32, a), y = __builtin_bit_cast(v4i32, b); return __builtin_shufflevector(x, y, 0, 1, 2, 3, 4, 5, 6, 7); }
template <class Epi, class Sched, int F8 = 0  >
__device__ __forceinline__ void gemm_phase(PG8_LAS unsigned char* lds, const Gemm g, const Sched& S, const Epi& E) {
    const int tid = threadIdx.x, wid = __builtin_amdgcn_readfirstlane(tid >> 6), lane = tid & 63, wr = wid >> 2, wc = wid & 3, fr = lane & 15, fq = lane >> 4;
    const int K = g.K, nt = K / BK;
    unsigned voffA[2], voffB[2];
#pragma unroll
    for (int i = 0; i < 2; ++i) { int R, C; stage_rc(tid * 16 + i * 8192, R, C); const int Rb = Epi::PERM ? ((R & ~31) + perm32(R & 31)) : R;
        voffA[i] = (unsigned)(R * g.lda + C) * 2u; voffB[i] = (unsigned)(Rb * g.ldb + C) * 2u; }
    const size_t kstep = (size_t)(BK * 2);
    const size_t hstepA = (size_t)HALF * g.lda * 2, hstepB = (size_t)HALF * g.ldb * 2;
    const size_t tstepA = 2 * hstepA, tstepB = 2 * hstepB;
    const unsigned ldsw = (unsigned)wid * 1024u;
    const int aoff = lds_byte(wr * 64 + fr, fq * 8), boff = lds_byte(wc * 32 + fr, fq * 8);
#define PG8_SA(b, h) (((b) * 2 + (h)) * HTB)
#define PG8_SB(b, h) ((4 + (b) * 2 + (h)) * HTB)
#define PG8_STAGE(bufoff, gbase, voff) do { _Pragma("unroll") for (int _i = 0; _i < 2; ++_i) \
        __builtin_amdgcn_global_load_lds((const unsigned*)((const char*)(gbase) + (voff)[_i]), (PG8_LAS unsigned*)(lds + (bufoff) + ldsw + _i * 8192), 16, 0, 0); } while (0)
#define PG8_LD16(off) (*(const PG8_LAS bf16x8*)(lds + (off)))
#define PG8_LDA(dst, b, h) do { if constexpr (F8 != 0) { _Pragma("unroll") for (int m = 0; m < 4; ++m) dst##8[m] = cat32(PG8_LD16(PG8_SA(b, h) + aoff + m * 2048), PG8_LD16(PG8_SA(b, h) + aoff + m * 2048 + 1024)); } \
      else { _Pragma("unroll") for (int m = 0; m < 4; ++m) _Pragma("unroll") for (int k = 0; k < 2; ++k) dst[m][k] = PG8_LD16(PG8_SA(b, h) + aoff + m * 2048 + k * 1024); } } while (0)
#define PG8_LDB(dst, b, h) do { if constexpr (F8 != 0) { _Pragma("unroll") for (int n = 0; n < 2; ++n) dst##8[n] = cat32(PG8_LD16(PG8_SB(b, h) + boff + n * 2048), PG8_LD16(PG8_SB(b, h) + boff + n * 2048 + 1024)); } \
      else { _Pragma("unroll") for (int n = 0; n < 2; ++n) _Pragma("unroll") for (int k = 0; k < 2; ++k) dst[n][k] = PG8_LD16(PG8_SB(b, h) + boff + n * 2048 + k * 1024); } } while (0)
#define PG8_MMA(ai, bj, At, Bt) do { __builtin_amdgcn_s_setprio(1); if constexpr (F8 == 2) { \
        _Pragma("unroll") for (int m = 0; m < 4; ++m) asm volatile("" : "+v"(At##8[m])); _Pragma("unroll") for (int n = 0; n < 2; ++n) asm volatile("" : "+v"(Bt##8[n]));   \
        _Pragma("unroll") for (int m = 0; m < 4; ++m) _Pragma("unroll") for (int n = 0; n < 2; ++n) \
        asm volatile("v_mfma_scale_f32_16x16x128_f8f6f4 %0, %1, %2, %0, %3, %4 op_sel_hi:[0,0,0] cbsz:2 blgp:2" : "+v"(acc[ai][bj][m][n]) : "v"(lo6(Bt##8[n])), "v"(lo6(At##8[m])), "v"(Bt##8[n][6]), "v"(At##8[m][6])); } \
      else if constexpr (F8 == 1) { _Pragma("unroll") for (int m = 0; m < 4; ++m) _Pragma("unroll") for (int n = 0; n < 2; ++n) \
        asm volatile("v_mfma_scale_f32_16x16x128_f8f6f4 %0, %1, %2, %0, %3, %3 op_sel_hi:[0,0,0]" : "+v"(acc[ai][bj][m][n]) : "v"(Bt##8[n]), "v"(At##8[m]), "v"(sc8)); } \
      else { _Pragma("unroll") for (int m = 0; m < 4; ++m) _Pragma("unroll") for (int n = 0; n < 2; ++n) _Pragma("unroll") for (int k = 0; k < 2; ++k) \
        acc[ai][bj][m][n] = __builtin_amdgcn_mfma_f32_16x16x32_bf16(Bt[n][k], At[m][k], acc[ai][bj][m][n], 0, 0, 0); } __builtin_amdgcn_s_setprio(0); } while (0)
#define PG8_WAIT_V(n) asm volatile("s_waitcnt vmcnt(" #n ")" ::: "memory")
#define PG8_WAIT_L(n) asm volatile("s_waitcnt lgkmcnt(" #n ")" ::: "memory")
#define PG8_BAR __builtin_amdgcn_s_barrier()
#define PG8_SCHED __builtin_amdgcn_sched_barrier(0)
    Unit cur, nxt; int ui = 0;
    if (!S.next(0, cur)) return;
    f32x4 acc[2][2][4][2];
#pragma unroll
    for (int a = 0; a < 2; ++a)
#pragma unroll
        for (int b = 0; b < 2; ++b)
#pragma unroll
            for (int m = 0; m < 4; ++m)
#pragma unroll
                for (int n = 0; n < 2; ++n) acc[a][b][m][n] = (f32x4){0.f, 0.f, 0.f, 0.f};
    const int sc8 = 0x7f7f7f7f;
    bf16x8 At[4][2], B0[2][2], B1[2][2]; v8i32 At8[4], B08[2], B18[2];
    const char* cA = (const char*)g.A + (size_t)cur.pm * tstepA; const char* cB = (const char*)g.Bt + (size_t)cur.pb * tstepB;
    PG8_STAGE(PG8_SB(0, 0), cB, voffB); PG8_STAGE(PG8_SB(0, 1), cB + hstepB, voffB); PG8_STAGE(PG8_SA(0, 0), cA, voffA); PG8_STAGE(PG8_SA(0, 1), cA + hstepA, voffA);
    if (wr == 1) PG8_BAR;
    PG8_WAIT_V(2); PG8_BAR;
    PG8_STAGE(PG8_SB(1, 0), cB + kstep, voffB); PG8_STAGE(PG8_SA(1, 0), cA + kstep, voffA); PG8_STAGE(PG8_SB(1, 1), cB + hstepB + kstep, voffB);
    PG8_WAIT_V(6); PG8_BAR;
    for (;;) {
        const bool has_next = S.next(ui + 1, nxt);
        const char* nA = has_next ? (const char*)g.A + (size_t)nxt.pm * tstepA : cA; const char* nB = has_next ? (const char*)g.Bt + (size_t)nxt.pb * tstepB : cB;
        for (int t = 0; t < nt; t += 2) {
            const bool last = (t == nt - 2);
            const char* a1 = cA + (size_t)(t + 1) * kstep;
            const char* a2 = last ? nA : cA + (size_t)(t + 2) * kstep; const char* b2 = last ? nB : cB + (size_t)(t + 2) * kstep;
            const char* a3 = a2 + kstep; const char* b3 = b2 + kstep;
            PG8_LDB(B0, 0, 0); PG8_LDB(B1, 0, 1); PG8_SCHED; PG8_LDA(At, 0, 0); PG8_STAGE(PG8_SA(1, 1), a1 + hstepA, voffA);
            PG8_WAIT_V(8); PG8_WAIT_L(0); PG8_BAR; PG8_MMA(0, 0, At, B0); PG8_MMA(0, 1, At, B1); PG8_BAR; PG8_SCHED;
            PG8_LDA(At, 0, 1); PG8_STAGE(PG8_SB(0, 0), b2, voffB); PG8_STAGE(PG8_SB(0, 1), b2 + hstepB, voffB); PG8_STAGE(PG8_SA(0, 0), a2, voffA);
            PG8_WAIT_V(8); PG8_WAIT_L(0); PG8_BAR; PG8_MMA(1, 0, At, B0); PG8_MMA(1, 1, At, B1); PG8_BAR; PG8_SCHED;
            PG8_LDB(B0, 1, 0); PG8_LDB(B1, 1, 1); PG8_SCHED; PG8_LDA(At, 1, 0); PG8_STAGE(PG8_SA(0, 1), a2 + hstepA, voffA);
            PG8_WAIT_V(8); PG8_WAIT_L(0); PG8_BAR; PG8_MMA(0, 0, At, B0); PG8_MMA(0, 1, At, B1); PG8_BAR; PG8_SCHED;
            PG8_LDA(At, 1, 1); PG8_STAGE(PG8_SB(1, 0), b3, voffB); PG8_STAGE(PG8_SB(1, 1), b3 + hstepB, voffB); PG8_STAGE(PG8_SA(1, 0), a3, voffA);
            PG8_WAIT_V(8); PG8_WAIT_L(0); PG8_BAR; PG8_MMA(1, 0, At, B0); PG8_MMA(1, 1, At, B1); PG8_BAR; PG8_SCHED;
        }
        if (wr == 0) PG8_BAR;
        if constexpr (F8 != 0) asm volatile("s_nop 15\n\ts_nop 15" ::: "memory");
        { int fr_ = fr, fq_ = fq; asm volatile("" : "+v"(fr_), "+v"(fq_));
          E(acc, cur, wr, wc, fr_, fq_); }
        if (!has_next) break;
#pragma unroll
        for (int a = 0; a < 2; ++a)
#pragma unroll
            for (int b = 0; b < 2; ++b)
#pragma unroll
                for (int m = 0; m < 4; ++m)
#pragma unroll
                    for (int n = 0; n < 2; ++n) acc[a][b][m][n] = (f32x4){0.f, 0.f, 0.f, 0.f};
        cur = nxt; cA = nA; cB = nB; ++ui;
        if (wr == 1) PG8_BAR;
    }
    PG8_WAIT_V(0);
    PG8_BAR;
#undef PG8_SA
#undef PG8_SB
#undef PG8_STAGE
#undef PG8_LDA
#undef PG8_LD16
#undef PG8_LDB
#undef PG8_MMA
#undef PG8_WAIT_V
#undef PG8_WAIT_L
#undef PG8_BAR
#undef PG8_SCHED
}
}

namespace att {
using bf16x8 = __attribute__((ext_vector_type(8))) short;
using s16x4  = __attribute__((ext_vector_type(4))) short;
using f32x16 = __attribute__((ext_vector_type(16))) float;
using u32x4  = __attribute__((ext_vector_type(4))) unsigned;
typedef unsigned short bf16_t;
constexpr int NW = 8, QBLK = 32, KVBLK = 64, NT = SK / KVBLK;
constexpr int KCS = 1040;
constexpr int SHM_V = KVBLK * 128 * 2, SHM_K = 8 * KCS;
constexpr int LDS_BYTES = 3 * 8192 + 3 * 16384 + NW * 256;
constexpr float SUM_THR = 8192.f;
constexpr float L_THR = 1.0995116e12f;
constexpr float SUM_THR8 = 256.f;
constexpr float THR2 = 8.f;
#define SBAR() __builtin_amdgcn_sched_barrier(0)
__device__ __forceinline__ int crow(int r, int hi) { return (r & 3) + 8 * (r >> 2) + 4 * hi; }
__device__ __forceinline__ unsigned cvtpk(float lo, float hi) { unsigned r; asm volatile("v_cvt_pk_bf16_f32 %0, %1, %2" : "=v"(r) : "v"(lo), "v"(hi)); return r; }
typedef float f32x2_t __attribute__((ext_vector_type(2))); typedef __bf16 bf16x2_t __attribute__((ext_vector_type(2)));
__device__ __forceinline__ unsigned cvtpk_s(float lo, float hi) { f32x2_t v = {lo, hi}; bf16x2_t b = __builtin_convertvector(v, bf16x2_t); return __builtin_bit_cast(unsigned, b); }
__device__ __forceinline__ float fadd_s(float a, float b) { float r; asm("v_add_f32_e32 %0, %1, %2" : "=v"(r) : "v"(a), "v"(b)); return r; }
__device__ __forceinline__ float bf_lo(unsigned w) { return __uint_as_float(w << 16); }
__device__ __forceinline__ float bf_hi(unsigned w) { return __uint_as_float(w & 0xffff0000u); }

__device__ __forceinline__ void partialSM(f32x16& p0, f32x16& p1, float& m_reg, float& alpha) {
  float pmax = p0[0];
#pragma unroll
  for (int r = 1; r < 16; ++r) pmax = fmaxf(pmax, p0[r]);
#pragma unroll
  for (int r = 0; r < 16; ++r) pmax = fmaxf(pmax, p1[r]);
  { auto rr = __builtin_amdgcn_permlane32_swap(__float_as_uint(pmax), __float_as_uint(pmax), false, false);
    pmax = fmaxf(__uint_as_float(rr[0]), __uint_as_float(rr[1])); }
  float mn;
  if (__builtin_expect(__all(pmax - m_reg <= THR2), 1)) { mn = m_reg; alpha = 1.f; }
  else { mn = fmaxf(m_reg, pmax); alpha = __builtin_amdgcn_exp2f(m_reg - mn); m_reg = mn; }
#pragma unroll
  for (int r = 0; r < 16; ++r) p0[r] -= mn;
#pragma unroll
  for (int r = 0; r < 16; ++r) p1[r] -= mn;
#pragma unroll
  for (int r = 0; r < 16; ++r) p0[r] = __builtin_amdgcn_exp2f(p0[r]);
}
__device__ __forceinline__ void finishSM(f32x16& p0, f32x16& p1, float alpha, float& l_reg, bf16x8& pa0, bf16x8& pa1, bf16x8& pa2, bf16x8& pa3) {
#pragma unroll
  for (int r = 0; r < 16; ++r) p1[r] = __builtin_amdgcn_exp2f(p1[r]);
  float ps = 0;
#pragma unroll
  for (int r = 0; r < 16; ++r) ps += p0[r];
#pragma unroll
  for (int r = 0; r < 16; ++r) ps += p1[r];
  { auto rr = __builtin_amdgcn_permlane32_swap(__float_as_uint(ps), __float_as_uint(ps), false, false);
    ps = __uint_as_float(rr[0]) + __uint_as_float(rr[1]); }
  l_reg = l_reg * alpha + ps;
#define PK4(P, BASE, OUT) do { unsigned a0 = cvtpk(P[BASE + 0], P[BASE + 1]), a1 = cvtpk(P[BASE + 2], P[BASE + 3]);   \
    unsigned b0 = cvtpk(P[BASE + 4], P[BASE + 5]), b1 = cvtpk(P[BASE + 6], P[BASE + 7]);                              \
    auto r0 = __builtin_amdgcn_permlane32_swap(a0, b0, false, false); auto r1 = __builtin_amdgcn_permlane32_swap(a1, b1, false, false); \
    u32x4 w = {r0[0], r1[0], r0[1], r1[1]}; OUT = *reinterpret_cast<bf16x8*>(&w); } while (0)
  PK4(p0, 0, pa0); PK4(p0, 8, pa1); PK4(p1, 0, pa2); PK4(p1, 8, pa3);
#undef PK4
}
__device__ __forceinline__ void qkt(f32x16& p0, f32x16& p1, const char* Ks, const bf16x8* qr, int r32, int hi) {
  p0 = f32x16{}; p1 = f32x16{};
#pragma unroll
  for (int d0 = 0; d0 < 4; ++d0) {
    const bf16x8 b0 = *reinterpret_cast<const bf16x8*>(Ks + (2 * d0 + hi) * KCS + r32 * 16);
    const bf16x8 b1 = *reinterpret_cast<const bf16x8*>(Ks + (2 * d0 + hi) * KCS + 512 + r32 * 16);
    p0 = __builtin_amdgcn_mfma_f32_32x32x16_bf16(b0, qr[d0], p0, 0, 0, 0);
    p1 = __builtin_amdgcn_mfma_f32_32x32x16_bf16(b1, qr[d0], p1, 0, 0, 0); }
}
__device__ __forceinline__ int v_st(int k, int c) { const int kk = (k & ~0xC) | ((k & 4) << 1) | ((k & 8) >> 1); return ((kk >> 3) * 4 + (c >> 5)) * 512 + ((kk & 7) * 32 + (c & 31)) * 2; }
__device__ __forceinline__ int v_rd_base(int lane) { return ((lane & 3) << 3) | (((lane >> 2) & 3) << 6) | (((lane >> 4) & 1) << 5) | (((lane >> 5) & 1) << 8); }
constexpr int v_rd_off(int d0, int ks, int half) { return d0 * 512 + ks * 4096 + half * 2048; }
template <int OFF> __device__ __forceinline__ s16x4 tr_read(int vb) {
  s16x4 r; asm volatile("ds_read_b64_tr_b16 %0, %1 offset:%2" : "=&v"(r) : "v"(vb), "i"(OFF) : "memory"); return r;
}
template <int D0> __device__ __forceinline__ void pv_one(f32x16& od, int vb, bf16x8 pa0, bf16x8 pa1, bf16x8 pa2, bf16x8 pa3) {
  const s16x4 l0 = tr_read<v_rd_off(D0, 0, 0)>(vb), h0 = tr_read<v_rd_off(D0, 0, 1)>(vb), l1 = tr_read<v_rd_off(D0, 1, 0)>(vb), h1 = tr_read<v_rd_off(D0, 1, 1)>(vb);
  const s16x4 l2 = tr_read<v_rd_off(D0, 2, 0)>(vb), h2 = tr_read<v_rd_off(D0, 2, 1)>(vb), l3 = tr_read<v_rd_off(D0, 3, 0)>(vb), h3 = tr_read<v_rd_off(D0, 3, 1)>(vb);
  asm volatile("s_waitcnt lgkmcnt(0)" ::: "memory"); SBAR();
#define PK(L, H) (bf16x8){L[0], L[1], L[2], L[3], H[0], H[1], H[2], H[3]}
  od = __builtin_amdgcn_mfma_f32_32x32x16_bf16(pa0, PK(l0, h0), od, 0, 0, 0);
  od = __builtin_amdgcn_mfma_f32_32x32x16_bf16(pa1, PK(l1, h1), od, 0, 0, 0);
  od = __builtin_amdgcn_mfma_f32_32x32x16_bf16(pa2, PK(l2, h2), od, 0, 0, 0);
  od = __builtin_amdgcn_mfma_f32_32x32x16_bf16(pa3, PK(l3, h3), od, 0, 0, 0);
#undef PK
}
__device__ __forceinline__ void pv_d0(f32x16* o, int vb, bf16x8 pa0, bf16x8 pa1, bf16x8 pa2, bf16x8 pa3) {
  pv_one<0>(o[0], vb, pa0, pa1, pa2, pa3); pv_one<1>(o[1], vb, pa0, pa1, pa2, pa3); pv_one<2>(o[2], vb, pa0, pa1, pa2, pa3); pv_one<3>(o[3], vb, pa0, pa1, pa2, pa3);
}

constexpr int NSLOT = 3, KSLOT = 8192, VSLOT = 16384;
constexpr int R_K = 0, R_V = NSLOT * KSLOT, R_WS = R_V + NSLOT * VSLOT, RING_LDS = R_WS + NW * 256;
typedef __attribute__((address_space(3))) const char* lds_cptr;
typedef short v4i16_t __attribute__((ext_vector_type(4)));
__device__ __forceinline__ void glds16(const void* gsrc, unsigned lds_dst) { unsigned keep;
  asm volatile("s_mov_b32 %0, m0\n\ts_mov_b32 m0, %2\n\ts_nop 0\n\tglobal_load_lds_dwordx4 %1, off\n\ts_mov_b32 m0, %0" : "=&s"(keep) : "v"(gsrc), "s"(lds_dst) : "memory"); }
__device__ __forceinline__ s16x4 vtr(lds_cptr p) { return __builtin_bit_cast(s16x4, __builtin_amdgcn_ds_read_tr16_b64_v4i16((__attribute__((address_space(3))) v4i16_t*)p)); }
#define BAR_ONLY() asm volatile("s_barrier" ::: "memory")
#define WAIT_BAR() asm volatile("s_waitcnt vmcnt(0) lgkmcnt(0)\n\ts_barrier" ::: "memory")
#define LGKM_BAR() asm volatile("s_waitcnt lgkmcnt(0)\n\ts_barrier" ::: "memory")

template <bool FIRST>
__device__ __forceinline__ void softmax_seg(f32x16& p0, f32x16& p1, float& mhat, f32x16& negm, float& l_reg, f32x16 (&o)[4], float* wsf, int r32, int hi,
                                            bf16x8& pa0, bf16x8& pa1, bf16x8& pa2, bf16x8& pa3) {
  if (FIRST) {
    float a = fmaxf(fmaxf(p0[0], p0[1]), p1[0]), b = fmaxf(fmaxf(p0[2], p0[3]), p1[1]); a = fmaxf(fmaxf(a, p1[2]), p1[3]);
#pragma unroll
    for (int r = 4; r < 16; r += 4) { a = fmaxf(fmaxf(a, p0[r]), p0[r + 1]); b = fmaxf(fmaxf(b, p0[r + 2]), p0[r + 3]); a = fmaxf(fmaxf(a, p1[r]), p1[r + 1]); b = fmaxf(fmaxf(b, p1[r + 2]), p1[r + 3]); }
    float rm = fmaxf(a, b);
    { auto rr = __builtin_amdgcn_permlane32_swap(__float_as_uint(rm), __float_as_uint(rm), false, false); rm = fmaxf(__uint_as_float(rr[0]), __uint_as_float(rr[1])); }
    mhat += rm;
#pragma unroll
    for (int r = 0; r < 16; ++r) { p0[r] -= rm; p1[r] -= rm; }
#pragma unroll
    for (int r = 0; r < 16; ++r) negm[r] = -mhat;
    asm volatile("" : "+v"(negm));
  }
#pragma unroll
  for (int r = 0; r < 16; ++r) p0[r] = __builtin_amdgcn_exp2f(p0[r]);
#pragma unroll
  for (int r = 0; r < 16; ++r) p1[r] = __builtin_amdgcn_exp2f(p1[r]);
  float s0 = p0[0] + p0[1], s1 = p1[0] + p1[1];
#pragma unroll
  for (int r = 2; r < 16; ++r) { s0 += p0[r]; asm volatile("" : "+v"(s0)); s1 += p1[r]; asm volatile("" : "+v"(s1)); }
  float st = s0 + s1;
  if (!FIRST && __builtin_expect(__any(st > SUM_THR), 0)) {
    float a = fmaxf(fmaxf(p0[0], p0[1]), p1[0]), b = fmaxf(fmaxf(p0[2], p0[3]), p1[1]); a = fmaxf(fmaxf(a, p1[2]), p1[3]);
#pragma unroll
    for (int r = 4; r < 16; r += 4) { a = fmaxf(fmaxf(a, p0[r]), p0[r + 1]); b = fmaxf(fmaxf(b, p0[r + 2]), p0[r + 3]); a = fmaxf(fmaxf(a, p1[r]), p1[r + 1]); b = fmaxf(fmaxf(b, p1[r + 2]), p1[r + 3]); }
    float rm = fmaxf(a, b);
    { auto rr = __builtin_amdgcn_permlane32_swap(__float_as_uint(rm), __float_as_uint(rm), false, false); rm = fmaxf(__uint_as_float(rr[0]), __uint_as_float(rr[1])); }
    const float dl = fmaxf(ceilf(__builtin_amdgcn_logf(rm)), 0.f), f = __builtin_amdgcn_exp2f(-dl);
    mhat += dl; l_reg *= f; st *= f;
#pragma unroll
    for (int r = 0; r < 16; ++r) { p0[r] *= f; p1[r] *= f; }
#pragma unroll
    for (int r = 0; r < 16; ++r) negm[r] = -mhat;
    asm volatile("" : "+v"(negm));
    if (hi == 0) wsf[r32] = f; asm volatile("s_waitcnt lgkmcnt(0)" ::: "memory");
#pragma unroll
    for (int r = 0; r < 16; ++r) { const float fr = wsf[crow(r, hi)];
#pragma unroll
      for (int d = 0; d < 4; ++d) o[d][r] *= fr; }
  }
  l_reg += st;
#define PK8(P, BASE, OUT) do { u32x4 w = {cvtpk_s(P[BASE + 0], P[BASE + 1]), cvtpk_s(P[BASE + 2], P[BASE + 3]), cvtpk_s(P[BASE + 4], P[BASE + 5]), cvtpk_s(P[BASE + 6], P[BASE + 7])}; OUT = *reinterpret_cast<bf16x8*>(&w); } while (0)
  PK8(p0, 0, pa0); PK8(p0, 8, pa1); PK8(p1, 0, pa2); PK8(p1, 8, pa3);
#undef PK8
}

__device__ __forceinline__ void flash_pass(const bf16_t* __restrict__ Qrow, const bf16_t* __restrict__ Kh, const bf16_t* __restrict__ Vh, char* lds, f32x16 (&o)[4], float& l_out) {
  int tid = threadIdx.x; asm volatile("" : "+v"(tid));
  const int lane = tid & 63, r32 = lane & 31, hi = lane >> 5; const int wid = __builtin_amdgcn_readfirstlane(tid >> 6), half = wid >> 2;
  const unsigned lds0 = (unsigned)(uintptr_t)lds;
  float* wsf = (float*)(lds + R_WS) + wid * 64;
  const bf16_t* ksrc = Kh + (long)(16 * (wid >> 1) + (lane >> 2)) * DM + (wid & 1) * 32 + (((lane & 3) ^ ((lane >> 4) & 3))) * 8;
  const bf16_t* vsrc = Vh + (long)(16 * (wid & 3) + (lane >> 2)) * DM + (wid >> 2) * 32 + (lane & 3) * 8;
  const unsigned kdst = lds0 + R_K + wid * 1024, vdst = lds0 + R_V + wid * 1024;
#define DMA_K(t, slot) glds16(ksrc + (long)(t) * KVBLK * DM, (unsigned)__builtin_amdgcn_readfirstlane(kdst + (slot)))
#define DMA_V(t, slot) do { glds16(vsrc + (long)(t) * KVBLK * DM, (unsigned)__builtin_amdgcn_readfirstlane(vdst + (slot))); glds16(vsrc + (long)(t) * KVBLK * DM + 64, (unsigned)__builtin_amdgcn_readfirstlane(vdst + (slot) + 8192)); } while (0)
  const lds_cptr shm3 = (lds_cptr)lds;
  const lds_cptr kpl = shm3 + R_K + (r32 >> 4) * 2048 + (r32 & 15) * 64;
  const lds_cptr kpe = kpl + ((hi ^ ((r32 >> 2) & 3)) * 16), kpo = kpl + (((2 + hi) ^ ((r32 >> 2) & 3)) * 16);
  const lds_cptr vp0 = shm3 + R_V + ((lane >> 4) & 1) * 32 + (lane & 3) * 8 + (4 * hi + ((lane & 15) >> 2)) * 64;
  DMA_K(0, 0); DMA_K(1, KSLOT); DMA_V(0, 0); DMA_K(2, 2 * KSLOT); DMA_V(1, VSLOT);
  bf16x8 qr[4];
#pragma unroll
  for (int d0 = 0; d0 < 4; ++d0) qr[d0] = *reinterpret_cast<const bf16x8*>(Qrow + d0 * 16);
#pragma unroll
  for (int d = 0; d < 4; ++d) o[d] = f32x16{};
  float mhat = 0.f, l_reg = 0.f; f32x16 negm;
  { float z; asm volatile("v_mov_b32 %0, 0" : "=v"(z));
#pragma unroll
    for (int r = 0; r < 16; ++r) negm[r] = z; }
  f32x16 p0, p1; bf16x8 pa0, pa1, pa2, pa3;
#define KLD(slot) do { _Pragma("unroll") for (int d0 = 0; d0 < 4; ++d0) { const lds_cptr kq_ = ((d0 & 1) ? kpo : kpe) + (slot) + (d0 >> 1) * 1024; kf[2 * d0] = *(const __attribute__((address_space(3))) bf16x8*)(kq_); kf[2 * d0 + 1] = *(const __attribute__((address_space(3))) bf16x8*)(kq_ + 4096); } } while (0)
#define QKM() do { p0 = __builtin_amdgcn_mfma_f32_32x32x16_bf16(kf[0], qr[0], negm, 0, 0, 0); p1 = __builtin_amdgcn_mfma_f32_32x32x16_bf16(kf[1], qr[0], negm, 0, 0, 0); \
    _Pragma("unroll") for (int d0 = 1; d0 < 4; ++d0) { p0 = __builtin_amdgcn_mfma_f32_32x32x16_bf16(kf[2 * d0], qr[d0], p0, 0, 0, 0); p1 = __builtin_amdgcn_mfma_f32_32x32x16_bf16(kf[2 * d0 + 1], qr[d0], p1, 0, 0, 0); } } while (0)
#define QKT(kp) do { KLD(kp); QKM(); } while (0)
#define VLD(L, H, vp, D0) do { _Pragma("unroll") for (int ks = 0; ks < 4; ++ks) { L[ks] = vtr((vp) + ((D0) >> 1) * 8192 + ((D0) & 1) * 4096 + ks * 1024); H[ks] = vtr((vp) + ((D0) >> 1) * 8192 + ((D0) & 1) * 4096 + ks * 1024 + 512); } } while (0)
#define VFRG(L, H, k) ((bf16x8){L[k][0], L[k][1], L[k][2], L[k][3], H[k][0], H[k][1], H[k][2], H[k][3]})
#define PVM(L, H, D0) do { o[D0] = __builtin_amdgcn_mfma_f32_32x32x16_bf16(pa0, VFRG(L, H, 0), o[D0], 0, 0, 0); o[D0] = __builtin_amdgcn_mfma_f32_32x32x16_bf16(pa1, VFRG(L, H, 1), o[D0], 0, 0, 0); \
    o[D0] = __builtin_amdgcn_mfma_f32_32x32x16_bf16(pa2, VFRG(L, H, 2), o[D0], 0, 0, 0); o[D0] = __builtin_amdgcn_mfma_f32_32x32x16_bf16(pa3, VFRG(L, H, 3), o[D0], 0, 0, 0); } while (0)
  bf16x8 kf[8]; s16x4 la[4], ha[4], lb[4], hb[4], lc[4], hc[4];
  WAIT_BAR();
  QKT(0);
  softmax_seg<true>(p0, p1, mhat, negm, l_reg, o, wsf, r32, hi, pa0, pa1, pa2, pa3);
  if (half) BAR_ONLY();
  int ks_next = KSLOT, vs_cur = 0;
#pragma unroll 1
  for (int j = 0; j < NT - 1; ++j) {
    { const lds_cptr vp = vp0 + vs_cur;
      __builtin_amdgcn_s_setprio(3);
      SBAR();
      KLD(ks_next); VLD(la, ha, vp, 0); VLD(lb, hb, vp, 1);
      QKM();
      VLD(lc, hc, vp, 2);
      PVM(la, ha, 0);
      VLD(la, ha, vp, 3);
      PVM(lb, hb, 1); PVM(lc, hc, 2); PVM(la, ha, 3);
      __builtin_amdgcn_sched_group_barrier(0x100, 4, 0);
#pragma unroll
      for (int g_ = 0; g_ < 18; ++g_) { __builtin_amdgcn_sched_group_barrier(0x8, 1, 0); __builtin_amdgcn_sched_group_barrier(0x100, 2, 0); }
#pragma unroll
      for (int g_ = 0; g_ < 6; ++g_) __builtin_amdgcn_sched_group_barrier(0x8, 1, 0);
      SBAR(); }
    __builtin_amdgcn_s_setprio(0);
    WAIT_BAR();
    if (j + 3 < NT) DMA_K(j + 3, (ks_next == KSLOT) ? 0 : ((ks_next == 2 * KSLOT) ? KSLOT : 2 * KSLOT));
    if (j + 2 < NT) DMA_V(j + 2, (vs_cur == 0) ? 2 * VSLOT : vs_cur - VSLOT);
    ks_next = (ks_next == 2 * KSLOT) ? 0 : ks_next + KSLOT; vs_cur = (vs_cur == 2 * VSLOT) ? 0 : vs_cur + VSLOT;
    softmax_seg<false>(p0, p1, mhat, negm, l_reg, o, wsf, r32, hi, pa0, pa1, pa2, pa3);
    LGKM_BAR();
  }
  { const lds_cptr vp = vp0 + vs_cur;
    __builtin_amdgcn_s_setprio(3);
    SBAR(); VLD(la, ha, vp, 0); VLD(lb, hb, vp, 1);
    SBAR(); PVM(la, ha, 0); VLD(la, ha, vp, 2);
    SBAR(); PVM(lb, hb, 1); VLD(lb, hb, vp, 3);
    SBAR(); PVM(la, ha, 2);
    SBAR(); PVM(lb, hb, 3); SBAR(); __builtin_amdgcn_s_setprio(0); WAIT_BAR(); }
  if (!half) BAR_ONLY();
  { auto rr = __builtin_amdgcn_permlane32_swap(__float_as_uint(l_reg), __float_as_uint(l_reg), false, false); l_reg = __uint_as_float(rr[0]) + __uint_as_float(rr[1]); }
  l_out = l_reg;
#undef DMA_K
#undef DMA_V
#undef QKT
#undef KLD
#undef QKM
#undef VLD
#undef VFRG
#undef PVM
}

__device__ __forceinline__ void attn_unit(int b, int h, int qb, const bf16_t* Q, const bf16_t* Kall, const bf16_t* Vall, bf16_t* O, const float* subw, float lam, float* stash, char* lds) {
  const int tid = threadIdx.x, wid = tid >> 6, lane = tid & 63, r32 = lane & 31, hi = lane >> 5;
  const long qrow0 = (long)b * SEQ + qb * 256 + wid * QBLK;
  const bf16_t* Vh = Vall + (long)b * SK * DM + h * 128;
  float* ws = (float*)(lds + R_WS) + wid * 64;
  f32x16 o[4]; float l_reg;
#pragma unroll 1
  for (int c = 0; c < 2; ++c) {
    const bf16_t* Qrow = Q + (qrow0 + r32) * DM + h * 128 + c * 64 + hi * 8;
    const bf16_t* Kh = Kall + (long)b * SK * DM + h * 128 + c * 64;
    flash_pass(Qrow, Kh, Vh, lds, o, l_reg);
    if (hi == 0) ws[r32] = l_reg; asm volatile("s_waitcnt lgkmcnt(0)" ::: "memory");
    {
#pragma unroll
      for (int r = 0; r < 16; ++r) { const float rl = __builtin_amdgcn_rcpf(ws[crow(r, hi)]);
#pragma unroll
        for (int d0 = 0; d0 < 4; ++d0) o[d0][r] *= rl; }
    }
    int tt = tid; asm volatile("" : "+v"(tt));
    float* stl = stash + tt;
    if (c == 0) {
#pragma unroll
      for (int d0 = 0; d0 < 4; ++d0)
#pragma unroll
        for (int r = 0; r < 16; ++r) stl[(d0 * 16 + r) * 512] = o[d0][r];
    } else {
      const int ll = tt & 63, r32l = ll & 31, hil = ll >> 5;
      float ss[16];
#pragma unroll
      for (int r = 0; r < 16; ++r) ss[r] = 0.f;
#pragma unroll
      for (int d0 = 0; d0 < 4; ++d0) {
#pragma unroll
        for (int r = 0; r < 16; ++r) { const float v0 = stl[(d0 * 16 + r) * 512] - lam * o[d0][r]; o[d0][r] = v0; ss[r] += v0 * v0; }
        asm volatile("" ::: "memory"); }
#pragma unroll
      for (int r = 0; r < 16; ++r) { float s = ss[r];
        s += __uint_as_float(__builtin_amdgcn_ds_swizzle(__float_as_uint(s), (1 << 10) | 0x1f)); s += __uint_as_float(__builtin_amdgcn_ds_swizzle(__float_as_uint(s), (2 << 10) | 0x1f));
        s += __uint_as_float(__builtin_amdgcn_ds_swizzle(__float_as_uint(s), (4 << 10) | 0x1f)); s += __uint_as_float(__builtin_amdgcn_ds_swizzle(__float_as_uint(s), (8 << 10) | 0x1f));
        s += __uint_as_float(__builtin_amdgcn_ds_swizzle(__float_as_uint(s), (16 << 10) | 0x1f));
        ss[r] = rsqrtf(s * (1.0f / 128.0f) + EPS) * (1.0f - LAM_INIT); }
      asm volatile("s_waitcnt lgkmcnt(0)" ::: "memory");
      bf16_t* stg = (bf16_t*)(lds + (tt >> 6) * 8192);
      bf16_t* stgl = stg + hil * 4 * 128 + r32l;
#pragma unroll
      for (int d0 = 0; d0 < 4; ++d0) { const float sw = subw[32 * d0 + r32l];
#pragma unroll
        for (int r = 0; r < 16; ++r) { const unsigned w = cvtpk(o[d0][r] * ss[r] * sw, 0.f); stgl[((r & 3) + 8 * (r >> 2)) * 128 + 32 * d0] = (bf16_t)w; } }
      asm volatile("s_waitcnt lgkmcnt(0)" ::: "memory");
      bf16_t* Ow = O + (qrow0 + (ll >> 4)) * DM + h * 128 + (ll & 15) * 8; const bf16_t* srd = stg + (ll >> 4) * 128 + (ll & 15) * 8;
#pragma unroll
      for (int i = 0; i < 8; ++i) { const u32x4 v = *(const u32x4*)(srd + i * 4 * 128); *(u32x4*)(Ow + (long)i * 4 * DM) = v; }
    }
    asm volatile("s_waitcnt vmcnt(0) lgkmcnt(0)\n\ts_barrier" ::: "memory");
  }
}

__device__ __forceinline__ void flash_pass8b(const unsigned char* __restrict__ Q8row, const unsigned char* __restrict__ K8h, const bf16_t* __restrict__ Vh, char* lds, f32x16 (&o)[4], float& l_out) {
  int tid = threadIdx.x; asm volatile("" : "+v"(tid));
  const int lane = tid & 63, r32 = lane & 31, hi = lane >> 5; const int wid = __builtin_amdgcn_readfirstlane(tid >> 6), half = wid >> 2;
  const unsigned lds0 = (unsigned)(uintptr_t)lds;
  float* wsf = (float*)(lds + R_WS) + wid * 64;
  const unsigned char* ksrc = K8h + (wid & 3) * 1024 + lane * 16;
  const bf16_t* vsrc = Vh + (long)(16 * (wid & 3) + (lane >> 2)) * DM + (wid >> 2) * 32 + (lane & 3) * 8;
  const unsigned kdst = lds0 + R_K + (wid & 3) * 1024, vdst = lds0 + R_V + wid * 1024;
#define DMA_K(t, slot) do { if (wid < 4) glds16(ksrc + (long)(t) * 4096, (unsigned)__builtin_amdgcn_readfirstlane(kdst + (slot))); } while (0)
#define DMA_V(t, slot) do { glds16(vsrc + (long)(t) * KVBLK * DM, (unsigned)__builtin_amdgcn_readfirstlane(vdst + (slot))); glds16(vsrc + (long)(t) * KVBLK * DM + 64, (unsigned)__builtin_amdgcn_readfirstlane(vdst + (slot) + 8192)); } while (0)
  const lds_cptr shm3 = (lds_cptr)lds;
  const lds_cptr kq0 = shm3 + R_K + r32 * 64 + (((2 * hi) ^ ((r32 >> 2) & 3)) * 16), kq1 = shm3 + R_K + r32 * 64 + (((2 * hi + 1) ^ ((r32 >> 2) & 3)) * 16);
  const lds_cptr vp0 = shm3 + R_V + ((lane >> 4) & 1) * 32 + (lane & 3) * 8 + (4 * hi + ((lane & 15) >> 2)) * 64;
  DMA_K(0, 0); DMA_K(1, KSLOT); DMA_V(0, 0); DMA_K(2, 2 * KSLOT); DMA_V(1, VSLOT);
  pg8::v8i32 q8 = pg8::cat32(*reinterpret_cast<const bf16x8*>(Q8row), *reinterpret_cast<const bf16x8*>(Q8row + 16));
#pragma unroll
  for (int d = 0; d < 4; ++d) o[d] = f32x16{};
  float mhat = 0.f, l_reg = 0.f; f32x16 negm;
  { float z; asm volatile("v_mov_b32 %0, 0" : "=v"(z));
#pragma unroll
    for (int r = 0; r < 16; ++r) negm[r] = z; }
  int sc8 = 0x7f7f7f7f; asm volatile("" : "+v"(sc8));
  asm volatile("s_waitcnt vmcnt(0)" ::: "memory"); asm volatile("" : "+v"(q8));
  f32x16 p0, p1; bf16x8 pa0, pa1, pa2, pa3;
#define KLD8(slot) do { _Pragma("unroll") for (int blk = 0; blk < 2; ++blk) kf8[blk] = pg8::cat32(*(const __attribute__((address_space(3))) bf16x8*)(kq0 + (slot) + blk * 2048), *(const __attribute__((address_space(3))) bf16x8*)(kq1 + (slot) + blk * 2048)); } while (0)
#define QKM8() do { asm volatile("" : "+v"(kf8[0])); asm volatile("" : "+v"(kf8[1])); \
    asm volatile("v_mfma_scale_f32_32x32x64_f8f6f4 %0, %1, %2, %3, %4, %4 op_sel_hi:[0,0,0]" : "=&v"(p0) : "v"(kf8[0]), "v"(q8), "v"(negm), "v"(sc8)); \
    asm volatile("v_mfma_scale_f32_32x32x64_f8f6f4 %0, %1, %2, %3, %4, %4 op_sel_hi:[0,0,0]" : "=&v"(p1) : "v"(kf8[1]), "v"(q8), "v"(negm), "v"(sc8)); } while (0)
#define VLD(L, H, vp, D0) do { _Pragma("unroll") for (int ks = 0; ks < 4; ++ks) { L[ks] = vtr((vp) + ((D0) >> 1) * 8192 + ((D0) & 1) * 4096 + ks * 1024); H[ks] = vtr((vp) + ((D0) >> 1) * 8192 + ((D0) & 1) * 4096 + ks * 1024 + 512); } } while (0)
#define VFRG(L, H, k) ((bf16x8){L[k][0], L[k][1], L[k][2], L[k][3], H[k][0], H[k][1], H[k][2], H[k][3]})
#define PVM(L, H, D0) do { o[D0] = __builtin_amdgcn_mfma_f32_32x32x16_bf16(pa0, VFRG(L, H, 0), o[D0], 0, 0, 0); o[D0] = __builtin_amdgcn_mfma_f32_32x32x16_bf16(pa1, VFRG(L, H, 1), o[D0], 0, 0, 0); \
    o[D0] = __builtin_amdgcn_mfma_f32_32x32x16_bf16(pa2, VFRG(L, H, 2), o[D0], 0, 0, 0); o[D0] = __builtin_amdgcn_mfma_f32_32x32x16_bf16(pa3, VFRG(L, H, 3), o[D0], 0, 0, 0); } while (0)
  pg8::v8i32 kf8[2]; s16x4 la[4], ha[4], lb[4], hb[4], lc[4], hc[4];
  WAIT_BAR();
  KLD8(0); QKM8();
  asm volatile("s_nop 15\n\ts_nop 15" : "+v"(p0), "+v"(p1), "+v"(negm));
  softmax_seg<true>(p0, p1, mhat, negm, l_reg, o, wsf, r32, hi, pa0, pa1, pa2, pa3);
  if (half) BAR_ONLY();
  int ks_next = KSLOT, vs_cur = 0;
#pragma unroll 1
  for (int j = 0; j < NT - 1; ++j) {
    { const lds_cptr vp = vp0 + vs_cur;
      __builtin_amdgcn_s_setprio(3);
      SBAR();
      KLD8(ks_next); VLD(la, ha, vp, 0); VLD(lb, hb, vp, 1);
      SBAR();
      QKM8();
      SBAR();
      VLD(lc, hc, vp, 2);
      PVM(la, ha, 0);
      VLD(la, ha, vp, 3);
      PVM(lb, hb, 1); PVM(lc, hc, 2); PVM(la, ha, 3);
#pragma unroll
      for (int g_ = 0; g_ < 16; ++g_) { __builtin_amdgcn_sched_group_barrier(0x8, 1, 0); __builtin_amdgcn_sched_group_barrier(0x100, 1, 0); }
      SBAR(); }
    __builtin_amdgcn_s_setprio(0);
    WAIT_BAR();
    if (j + 3 < NT) DMA_K(j + 3, (ks_next == KSLOT) ? 0 : ((ks_next == 2 * KSLOT) ? KSLOT : 2 * KSLOT));
    if (j + 2 < NT) DMA_V(j + 2, (vs_cur == 0) ? 2 * VSLOT : vs_cur - VSLOT);
    ks_next = (ks_next == 2 * KSLOT) ? 0 : ks_next + KSLOT; vs_cur = (vs_cur == 2 * VSLOT) ? 0 : vs_cur + VSLOT;
    softmax_seg<false>(p0, p1, mhat, negm, l_reg, o, wsf, r32, hi, pa0, pa1, pa2, pa3);
    LGKM_BAR();
  }
  { const lds_cptr vp = vp0 + vs_cur;
    __builtin_amdgcn_s_setprio(3);
    SBAR(); VLD(la, ha, vp, 0); VLD(lb, hb, vp, 1);
    SBAR(); PVM(la, ha, 0); VLD(la, ha, vp, 2);
    SBAR(); PVM(lb, hb, 1); VLD(lb, hb, vp, 3);
    SBAR(); PVM(la, ha, 2);
    SBAR(); PVM(lb, hb, 3); SBAR(); __builtin_amdgcn_s_setprio(0); WAIT_BAR(); }
  if (!half) BAR_ONLY();
  { auto rr = __builtin_amdgcn_permlane32_swap(__float_as_uint(l_reg), __float_as_uint(l_reg), false, false); l_reg = __uint_as_float(rr[0]) + __uint_as_float(rr[1]); }
  l_out = l_reg;
#undef DMA_K
#undef DMA_V
#undef KLD8
#undef QKM8
#undef VLD
#undef VFRG
#undef PVM
}

__device__ __forceinline__ void pack_half8(const f32x16& x, pg8::v8i32& P8, int base) {
#pragma unroll
  for (int w = 0; w < 4; ++w) { int a = __builtin_amdgcn_cvt_pk_fp8_f32(x[4 * w], x[4 * w + 1], P8[base + w], false); a = __builtin_amdgcn_cvt_pk_fp8_f32(x[4 * w + 2], x[4 * w + 3], a, true); P8[base + w] = a; }
}
template <bool FIRST, bool PACK = true>
__device__ __forceinline__ void softmax_seg8(f32x16& p0, f32x16& p1, float& mhat, f32x16& negm, float& l_reg, f32x16 (&o)[4], float* wsf, int r32, int hi,
                                            pg8::v8i32& P8) {
  if (FIRST) {
    float a = fmaxf(fmaxf(p0[0], p0[1]), p1[0]), b = fmaxf(fmaxf(p0[2], p0[3]), p1[1]); a = fmaxf(fmaxf(a, p1[2]), p1[3]);
#pragma unroll
    for (int r = 4; r < 16; r += 4) { a = fmaxf(fmaxf(a, p0[r]), p0[r + 1]); b = fmaxf(fmaxf(b, p0[r + 2]), p0[r + 3]); a = fmaxf(fmaxf(a, p1[r]), p1[r + 1]); b = fmaxf(fmaxf(b, p1[r + 2]), p1[r + 3]); }
    float rm = fmaxf(a, b);
    { auto rr = __builtin_amdgcn_permlane32_swap(__float_as_uint(rm), __float_as_uint(rm), false, false); rm = fmaxf(__uint_as_float(rr[0]), __uint_as_float(rr[1])); }
    rm -= 2.0f;
    mhat += rm;
#pragma unroll
    for (int r = 0; r < 16; ++r) { p0[r] -= rm; p1[r] -= rm; }
#pragma unroll
    for (int r = 0; r < 16; ++r) negm[r] = -mhat;
    asm volatile("" : "+v"(negm));
  }
#pragma unroll
  for (int r = 0; r < 16; ++r) p0[r] = __builtin_amdgcn_exp2f(p0[r]);
#pragma unroll
  for (int r = 0; r < 16; ++r) p1[r] = __builtin_amdgcn_exp2f(p1[r]);
  float s0 = p0[0] + p0[1], s1 = p1[0] + p1[1];
#pragma unroll
  for (int r = 2; r < 16; ++r) { s0 += p0[r]; asm volatile("" : "+v"(s0)); s1 += p1[r]; asm volatile("" : "+v"(s1)); }
  float st = s0 + s1;
  if (!FIRST && __builtin_expect(__any(st > SUM_THR8), 0)) {
    asm volatile("s_nop 15\n\ts_nop 15" : "+v"(o[0]), "+v"(o[1]), "+v"(o[2]), "+v"(o[3]));
    float a = fmaxf(fmaxf(p0[0], p0[1]), p1[0]), b = fmaxf(fmaxf(p0[2], p0[3]), p1[1]); a = fmaxf(fmaxf(a, p1[2]), p1[3]);
#pragma unroll
    for (int r = 4; r < 16; r += 4) { a = fmaxf(fmaxf(a, p0[r]), p0[r + 1]); b = fmaxf(fmaxf(b, p0[r + 2]), p0[r + 3]); a = fmaxf(fmaxf(a, p1[r]), p1[r + 1]); b = fmaxf(fmaxf(b, p1[r + 2]), p1[r + 3]); }
    float rm = fmaxf(a, b);
    { auto rr = __builtin_amdgcn_permlane32_swap(__float_as_uint(rm), __float_as_uint(rm), false, false); rm = fmaxf(__uint_as_float(rr[0]), __uint_as_float(rr[1])); }
    const float dl = fmaxf(ceilf(__builtin_amdgcn_logf(rm)) - 2.0f, 0.f), f = __builtin_amdgcn_exp2f(-dl);
    mhat += dl; l_reg *= f; st *= f;
#pragma unroll
    for (int r = 0; r < 16; ++r) { p0[r] *= f; p1[r] *= f; }
#pragma unroll
    for (int r = 0; r < 16; ++r) negm[r] = -mhat;
    asm volatile("" : "+v"(negm));
    if (hi == 0) wsf[r32] = f; asm volatile("s_waitcnt lgkmcnt(0)" ::: "memory");
#pragma unroll
    for (int r = 0; r < 16; ++r) { const float fr = wsf[crow(r, hi)];
#pragma unroll
      for (int d = 0; d < 4; ++d) o[d][r] *= fr; }
  }
  l_reg += st;
  if (PACK)
#pragma unroll
  for (int w = 0; w < 4; ++w) { int a = __builtin_amdgcn_cvt_pk_fp8_f32(p0[4 * w], p0[4 * w + 1], FIRST ? 0 : P8[w], false); a = __builtin_amdgcn_cvt_pk_fp8_f32(p0[4 * w + 2], p0[4 * w + 3], a, true); P8[w] = a;
    int c2 = __builtin_amdgcn_cvt_pk_fp8_f32(p1[4 * w], p1[4 * w + 1], FIRST ? 0 : P8[4 + w], false); c2 = __builtin_amdgcn_cvt_pk_fp8_f32(p1[4 * w + 2], p1[4 * w + 3], c2, true); P8[4 + w] = c2; }
}


__device__ __forceinline__ void flash_pass8(const unsigned char* __restrict__ Q8row, const unsigned char* __restrict__ K8h, const unsigned char* __restrict__ V8h, char* lds, f32x16 (&o)[4], float& l_out) {
  int tid = threadIdx.x; asm volatile("" : "+v"(tid));
  const int lane = tid & 63, r32 = lane & 31, hi = lane >> 5; const int wid = __builtin_amdgcn_readfirstlane(tid >> 6), half = wid >> 2;
  const unsigned lds0 = (unsigned)(uintptr_t)lds;
  float* wsf = (float*)(lds + R_WS) + wid * 64;
  const unsigned char* ksrc = K8h + (wid & 3) * 1024 + lane * 16;
  const unsigned char* vsrc = V8h + wid * 1024 + lane * 16;
  const unsigned kdst = lds0 + R_K + (wid & 3) * 1024, vdst = lds0 + R_V + wid * 1024;
#define DMA_K(t, slot) do { if (wid < 4) glds16(ksrc + (long)(t) * 4096, (unsigned)__builtin_amdgcn_readfirstlane(kdst + (slot))); } while (0)
#define DMA_V(t, slot) glds16(vsrc + (long)(t) * 8192, (unsigned)__builtin_amdgcn_readfirstlane(vdst + (slot)))
  const lds_cptr shm3 = (lds_cptr)lds;
  const lds_cptr kq0 = shm3 + R_K + r32 * 64 + (((2 * hi) ^ ((r32 >> 2) & 3)) * 16), kq1 = shm3 + R_K + r32 * 64 + (((2 * hi + 1) ^ ((r32 >> 2) & 3)) * 16);
  const lds_cptr vq0 = shm3 + R_V + r32 * 64 + (((2 * hi) ^ ((r32 >> 2) & 3)) * 16), vq1 = shm3 + R_V + r32 * 64 + (((2 * hi + 1) ^ ((r32 >> 2) & 3)) * 16);
  DMA_K(0, 0); DMA_K(1, KSLOT); DMA_V(0, 0); DMA_K(2, 2 * KSLOT); DMA_V(1, VSLOT);
  pg8::v8i32 q8;
  { const pg8::u32x4* qs = reinterpret_cast<const pg8::u32x4*>(Q8row); pg8::u32x4 w4[4];
#pragma unroll
    for (int k = 0; k < 4; ++k) w4[k] = qs[k];
    pg8::v16f32 xe, xo; float mx = 0.f;
#pragma unroll
    for (int i = 0; i < 16; ++i) { const unsigned w = w4[i >> 2][i & 3]; xe[i] = bf_lo(w); xo[i] = bf_hi(w); mx = fmaxf(mx, fmaxf(fabsf(xe[i]), fabsf(xo[i]))); }
    q8 = pg8::fp6_chunk(xe, xo, mx); }
#pragma unroll
  for (int d = 0; d < 4; ++d) o[d] = f32x16{};
  float mhat = 0.f, l_reg = 0.f; f32x16 negm;
  { float z; asm volatile("v_mov_b32 %0, 0" : "=v"(z));
#pragma unroll
    for (int r = 0; r < 16; ++r) negm[r] = z; }
  int sc8 = 0x7f7f7f7f; asm volatile("" : "+v"(sc8));
  asm volatile("s_waitcnt vmcnt(0)" ::: "memory"); asm volatile("" : "+v"(q8));
  f32x16 p0, p1; pg8::v8i32 P8, vf[4], kf8[2];
#define KLD8(slot) do { _Pragma("unroll") for (int blk = 0; blk < 2; ++blk) kf8[blk] = pg8::cat32(*(const __attribute__((address_space(3))) bf16x8*)(kq0 + (slot) + blk * 2048), *(const __attribute__((address_space(3))) bf16x8*)(kq1 + (slot) + blk * 2048)); } while (0)
#define QKM8() do { asm volatile("" : "+v"(kf8[0])); asm volatile("" : "+v"(kf8[1]));   \
    asm volatile("v_mfma_scale_f32_32x32x64_f8f6f4 %0, %1, %2, %3, %4, %5 op_sel_hi:[0,0,0] cbsz:2 blgp:2" : "=&v"(p0) : "v"(pg8::lo6(kf8[0])), "v"(pg8::lo6(q8)), "v"(negm), "v"(kf8[0][6]), "v"(q8[6])); \
    asm volatile("v_mfma_scale_f32_32x32x64_f8f6f4 %0, %1, %2, %3, %4, %5 op_sel_hi:[0,0,0] cbsz:2 blgp:2" : "=&v"(p1) : "v"(pg8::lo6(kf8[1])), "v"(pg8::lo6(q8)), "v"(negm), "v"(kf8[1][6]), "v"(q8[6])); } while (0)
#define QK1M8() do { asm volatile("" : "+v"(kf8[0])); \
    asm volatile("v_mfma_scale_f32_32x32x64_f8f6f4 %0, %1, %2, %3, %4, %5 op_sel_hi:[0,0,0] cbsz:2 blgp:2" : "=&v"(p0) : "v"(pg8::lo6(kf8[0])), "v"(pg8::lo6(q8)), "v"(negm), "v"(kf8[0][6]), "v"(q8[6])); } while (0)
#define QK2M8() do { asm volatile("" : "+v"(kf8[1])); \
    asm volatile("v_mfma_scale_f32_32x32x64_f8f6f4 %0, %1, %2, %3, %4, %5 op_sel_hi:[0,0,0] cbsz:2 blgp:2" : "=&v"(p1) : "v"(pg8::lo6(kf8[1])), "v"(pg8::lo6(q8)), "v"(negm), "v"(kf8[1][6]), "v"(q8[6])); } while (0)
#define VM_BAR8() asm volatile("s_waitcnt vmcnt(0)\n\ts_barrier" ::: "memory")
#define V8LD(vs) do { _Pragma("unroll") for (int D0 = 0; D0 < 4; ++D0) vf[D0] = pg8::cat32(*(const __attribute__((address_space(3))) bf16x8*)(vq0 + (vs) + D0 * 2048), *(const __attribute__((address_space(3))) bf16x8*)(vq1 + (vs) + D0 * 2048)); } while (0)
#define PVM8() do { asm volatile("" : "+v"(P8)); _Pragma("unroll") for (int D0 = 0; D0 < 4; ++D0) asm volatile("" : "+v"(vf[D0])); \
    _Pragma("unroll") for (int D0 = 0; D0 < 4; ++D0) asm volatile("v_mfma_scale_f32_32x32x64_f8f6f4 %0, %1, %2, %0, %3, %3 op_sel_hi:[0,0,0]" : "+v"(o[D0]) : "v"(P8), "v"(vf[D0]), "v"(sc8)); } while (0)
  WAIT_BAR();
  KLD8(0); QKM8();
  BAR_ONLY();
  asm volatile("s_nop 15\n\ts_nop 15" : "+v"(p0), "+v"(p1), "+v"(negm));
  softmax_seg8<true, false>(p0, p1, mhat, negm, l_reg, o, wsf, r32, hi, P8);
#pragma unroll
  for (int w = 0; w < 8; ++w) P8[w] = 0;
  int ks_next = KSLOT, vs_cur = 0;
  KLD8(ks_next);
  if (half) BAR_ONLY();
#pragma unroll 1
  for (int j = 0; j < NT - 1; ++j) {
    if (j + 3 < NT) DMA_K(j + 3, (ks_next == KSLOT) ? 0 : ((ks_next == 2 * KSLOT) ? KSLOT : 2 * KSLOT));
    if (j + 2 < NT) DMA_V(j + 2, (vs_cur == 0) ? 2 * VSLOT : vs_cur - VSLOT);
    __builtin_amdgcn_s_setprio(3);
    SBAR(); V8LD(vs_cur); SBAR();
    pack_half8(p0, P8, 0); SBAR();
    QK1M8(); SBAR();
    pack_half8(p1, P8, 4); SBAR();
    QK2M8();
    PVM8();
    SBAR(); __builtin_amdgcn_s_setprio(0);
    LGKM_BAR();
    ks_next = (ks_next == 2 * KSLOT) ? 0 : ks_next + KSLOT; vs_cur = (vs_cur == 2 * VSLOT) ? 0 : vs_cur + VSLOT;
    SBAR(); if (j + 2 < NT) KLD8(ks_next); SBAR();
    softmax_seg8<false, false>(p0, p1, mhat, negm, l_reg, o, wsf, r32, hi, P8);
    VM_BAR8();
  }
  { __builtin_amdgcn_s_setprio(3); SBAR(); V8LD(vs_cur); SBAR(); pack_half8(p0, P8, 0); pack_half8(p1, P8, 4); SBAR(); PVM8(); SBAR(); __builtin_amdgcn_s_setprio(0); WAIT_BAR(); }
  if (!half) BAR_ONLY();
  asm volatile("s_nop 15\n\ts_nop 15" : "+v"(o[0]), "+v"(o[1]), "+v"(o[2]), "+v"(o[3]));
  { auto rr = __builtin_amdgcn_permlane32_swap(__float_as_uint(l_reg), __float_as_uint(l_reg), false, false); l_reg = __uint_as_float(rr[0]) + __uint_as_float(rr[1]); }
  l_out = l_reg;
#undef DMA_K
#undef DMA_V
#undef KLD8
#undef QKM8
#undef V8LD
#undef PVM8
#undef QK1M8
#undef QK2M8
#undef VM_BAR8
}
__device__ __forceinline__ void attn_unit_88(int b, int h, int qb, const bf16_t* Vall, const unsigned char* V8T, const unsigned char* K8A, const unsigned char* K8B, const unsigned char* Q8A, const unsigned char* Q8B, bf16_t* O, const float* subw, float lam, float* stash, char* lds) {
  const int tid = threadIdx.x, wid = tid >> 6, lane = tid & 63, r32 = lane & 31, hi = lane >> 5;
  const long qrow0 = (long)b * SEQ + qb * 256 + wid * QBLK;
  const bf16_t* Vh = Vall + (long)b * SK * DM + h * 128;
  float* ws = (float*)(lds + R_WS) + wid * 64;
  f32x16 o[4]; float l_reg;
#pragma unroll 1
  for (int c = 0; c < 2; ++c) {
    const unsigned char* q8p = Q8A + ((size_t)(qrow0 + r32) * DM + h * 128 + c * 64 + hi * 32) * 2;        const unsigned char* k8p = (c ? K8B : K8A) + (size_t)(b * NH + h) * NT * 4096;
    flash_pass8(q8p, k8p, V8T + (size_t)(b * NH + h) * NT * 8192, lds, o, l_reg);
    if (hi == 0) ws[r32] = l_reg; asm volatile("s_waitcnt lgkmcnt(0)" ::: "memory");
    {
#pragma unroll
      for (int r = 0; r < 16; ++r) { const float rl = __builtin_amdgcn_rcpf(ws[crow(r, hi)]);
#pragma unroll
        for (int d0 = 0; d0 < 4; ++d0) o[d0][r] *= rl; }
    }
    int tt = tid; asm volatile("" : "+v"(tt));
    float* stl = stash + tt;
    if (c == 0) {
#pragma unroll
      for (int d0 = 0; d0 < 4; ++d0)
#pragma unroll
        for (int r = 0; r < 16; ++r) stl[(d0 * 16 + r) * 512] = o[d0][r];
    } else {
      const int ll = tt & 63, r32l = ll & 31, hil = ll >> 5;
      float ss[16];
#pragma unroll
      for (int r = 0; r < 16; ++r) ss[r] = 0.f;
#pragma unroll
      for (int d0 = 0; d0 < 4; ++d0) {
#pragma unroll
        for (int r = 0; r < 16; ++r) { const float v0 = stl[(d0 * 16 + r) * 512] - lam * o[d0][r]; o[d0][r] = v0; ss[r] += v0 * v0; }
        asm volatile("" ::: "memory"); }
#pragma unroll
      for (int r = 0; r < 16; ++r) { float s = ss[r];
        s += __uint_as_float(__builtin_amdgcn_ds_swizzle(__float_as_uint(s), (1 << 10) | 0x1f)); s += __uint_as_float(__builtin_amdgcn_ds_swizzle(__float_as_uint(s), (2 << 10) | 0x1f));
        s += __uint_as_float(__builtin_amdgcn_ds_swizzle(__float_as_uint(s), (4 << 10) | 0x1f)); s += __uint_as_float(__builtin_amdgcn_ds_swizzle(__float_as_uint(s), (8 << 10) | 0x1f));
        s += __uint_as_float(__builtin_amdgcn_ds_swizzle(__float_as_uint(s), (16 << 10) | 0x1f));
        ss[r] = rsqrtf(s * (1.0f / 128.0f) + EPS) * (1.0f - LAM_INIT); }
      asm volatile("s_waitcnt lgkmcnt(0)" ::: "memory");
      bf16_t* stg = (bf16_t*)(lds + (tt >> 6) * 8192);
      bf16_t* stgl = stg + hil * 4 * 128 + r32l;
#pragma unroll
      for (int d0 = 0; d0 < 4; ++d0) { const float sw = subw[32 * d0 + r32l];
#pragma unroll
        for (int r = 0; r < 16; ++r) { const unsigned w = cvtpk(o[d0][r] * ss[r] * sw, 0.f); stgl[((r & 3) + 8 * (r >> 2)) * 128 + 32 * d0] = (bf16_t)w; } }
      asm volatile("s_waitcnt lgkmcnt(0)" ::: "memory");
      bf16_t* Ow = O + (qrow0 + (ll >> 4)) * DM + h * 128 + (ll & 15) * 8; const bf16_t* srd = stg + (ll >> 4) * 128 + (ll & 15) * 8;
#pragma unroll
      for (int i = 0; i < 8; ++i) { const u32x4 v = *(const u32x4*)(srd + i * 4 * 128); *(u32x4*)(Ow + (long)i * 4 * DM) = v; }
    }
    asm volatile("s_waitcnt vmcnt(0) lgkmcnt(0)\n\ts_barrier" ::: "memory");
  }
}

typedef float f32x4a __attribute__((ext_vector_type(4)));
#define MF16(a, b, c) __builtin_amdgcn_mfma_f32_16x16x32_bf16(a, b, c, 0, 0, 0)
__device__ __forceinline__ float xg_max(float v) {
  v = fmaxf(v, __uint_as_float(__builtin_amdgcn_ds_swizzle(__float_as_uint(v), (16 << 10) | 0x1f)));
  auto rr = __builtin_amdgcn_permlane32_swap(__float_as_uint(v), __float_as_uint(v), false, false); return fmaxf(__uint_as_float(rr[0]), __uint_as_float(rr[1])); }
__device__ __forceinline__ float xg_sum(float v) {
  v += __uint_as_float(__builtin_amdgcn_ds_swizzle(__float_as_uint(v), (16 << 10) | 0x1f));
  auto rr = __builtin_amdgcn_permlane32_swap(__float_as_uint(v), __float_as_uint(v), false, false); return __uint_as_float(rr[0]) + __uint_as_float(rr[1]); }
__device__ __forceinline__ float max4(f32x4a v) { return fmaxf(fmaxf(v[0], v[1]), fmaxf(v[2], v[3])); }

template <bool FIRST>
__device__ __forceinline__ void softmax_seg16(f32x4a (&s)[2][4], float (&mhat)[2], f32x4a (&negm)[2], f32x4a (&lacc)[2], f32x4a (&o)[2][8], bf16x8 (&pa)[2][2]) {
  if (FIRST) {
#pragma unroll
    for (int qb = 0; qb < 2; ++qb) {
      const float rm = xg_max(fmaxf(fmaxf(max4(s[qb][0]), max4(s[qb][1])), fmaxf(max4(s[qb][2]), max4(s[qb][3]))));
      mhat[qb] += rm;
#pragma unroll
      for (int kb = 0; kb < 4; ++kb) s[qb][kb] -= rm;
#pragma unroll
      for (int i = 0; i < 4; ++i) negm[qb][i] = -mhat[qb];
    }
    asm volatile("" : "+v"(negm[0]), "+v"(negm[1]));
  }
#pragma unroll
  for (int qb = 0; qb < 2; ++qb)
#pragma unroll
    for (int kb = 0; kb < 4; ++kb)
#pragma unroll
      for (int i = 0; i < 4; ++i) s[qb][kb][i] = __builtin_amdgcn_exp2f(s[qb][kb][i]);
  if (!FIRST && __builtin_expect(__any(fmaxf(lacc[0][0], lacc[1][0]) > L_THR), 0)) {
#pragma unroll
    for (int qb = 0; qb < 2; ++qb) {
      const float dl = fmaxf(ceilf(__builtin_amdgcn_logf(lacc[qb][0])), 0.f), f = __builtin_amdgcn_exp2f(-dl);
      mhat[qb] += dl; lacc[qb] *= f;
#pragma unroll
      for (int kb = 0; kb < 4; ++kb) s[qb][kb] *= f;
#pragma unroll
      for (int i = 0; i < 4; ++i) negm[qb][i] = -mhat[qb];
#pragma unroll
      for (int db = 0; db < 8; ++db) o[qb][db] *= f;
    }
    asm volatile("" : "+v"(negm[0]), "+v"(negm[1]));
  }
#pragma unroll
  for (int qb = 0; qb < 2; ++qb)
#pragma unroll
    for (int st = 0; st < 2; ++st) { u32x4 w = {cvtpk_s(s[qb][2 * st][0], s[qb][2 * st][1]), cvtpk_s(s[qb][2 * st][2], s[qb][2 * st][3]), cvtpk_s(s[qb][2 * st + 1][0], s[qb][2 * st + 1][1]), cvtpk_s(s[qb][2 * st + 1][2], s[qb][2 * st + 1][3])};
      pa[qb][st] = *reinterpret_cast<bf16x8*>(&w); }
}

__device__ __forceinline__ void flash_pass16(const bf16_t* __restrict__ Qrow, const bf16_t* __restrict__ Kh, const bf16_t* __restrict__ Vh, char* lds, f32x4a (&o)[2][8], float (&l_out)[2]) {
  int tid = threadIdx.x; asm volatile("" : "+v"(tid));
  const int lane = tid & 63, l15 = lane & 15, g = lane >> 4; const int wid = __builtin_amdgcn_readfirstlane(tid >> 6), half = wid >> 2;
  const unsigned lds0 = (unsigned)(uintptr_t)lds;
  const bf16_t* ksrc = Kh + (long)(16 * (wid >> 1) + (lane >> 2)) * DM + (wid & 1) * 32 + (((lane & 3) ^ ((lane >> 4) & 3))) * 8;
  const bf16_t* vsrc = Vh + (long)(16 * (wid & 3) + (lane >> 2)) * DM + (wid >> 2) * 32 + (((lane & 3) ^ (2 * ((lane >> 4) & 1)))) * 8;
  const unsigned kdst = lds0 + R_K + wid * 1024, vdst = lds0 + R_V + wid * 1024;
#define DMA_K(t, slot) glds16(ksrc + (long)(t) * KVBLK * DM, (unsigned)__builtin_amdgcn_readfirstlane(kdst + (slot)))
#define DMA_V(t, slot) do { glds16(vsrc + (long)(t) * KVBLK * DM, (unsigned)__builtin_amdgcn_readfirstlane(vdst + (slot))); glds16(vsrc + (long)(t) * KVBLK * DM + 64, (unsigned)__builtin_amdgcn_readfirstlane(vdst + (slot) + 8192)); } while (0)
  const lds_cptr shm3 = (lds_cptr)lds;
  const lds_cptr kp = shm3 + R_K + l15 * 64 + ((g ^ ((l15 >> 2) & 3)) * 16);
  const lds_cptr vpl = shm3 + R_V + (4 * g + (l15 >> 2)) * 64 + (l15 & 3) * 8;
  const lds_cptr vpe0 = vpl + (g & 1) * 32, vpo0 = vpl + ((g & 1) ^ 1) * 32;
  DMA_K(0, 0); DMA_K(1, KSLOT); DMA_V(0, 0); DMA_K(2, 2 * KSLOT); DMA_V(1, VSLOT);
  bf16x8 qr[4];
#pragma unroll
  for (int i = 0; i < 4; ++i) qr[i] = *reinterpret_cast<const bf16x8*>(Qrow + (long)(i >> 1) * 16 * DM + (i & 1) * 32);
  float z; asm volatile("v_mov_b32 %0, 0" : "=v"(z));
#pragma unroll
  for (int qb = 0; qb < 2; ++qb)
#pragma unroll
    for (int db = 0; db < 8; ++db)
#pragma unroll
      for (int i = 0; i < 4; ++i) o[qb][db][i] = z;
  float mhat[2] = {0.f, 0.f}; f32x4a negm[2], lacc[2];
#pragma unroll
  for (int qb = 0; qb < 2; ++qb)
#pragma unroll
    for (int i = 0; i < 4; ++i) { negm[qb][i] = z; lacc[qb][i] = z; }
  const bf16x8 ones = {0x3f80, 0x3f80, 0x3f80, 0x3f80, 0x3f80, 0x3f80, 0x3f80, 0x3f80};
  f32x4a s[2][4]; bf16x8 pa[2][2];
  bf16x8 kf[8]; s16x4 va[8], vb[8], vc[8];
#define KLD16(slot) do { _Pragma("unroll") for (int ks = 0; ks < 2; ++ks) { _Pragma("unroll") for (int kb = 0; kb < 4; ++kb) kf[2 * kb + ks] = *(const __attribute__((address_space(3))) bf16x8*)(kp + (slot) + (2 * kb + ks) * 1024); } } while (0)
#define QKM16() do { _Pragma("unroll") for (int kb = 0; kb < 4; ++kb) { s[0][kb] = MF16(kf[2 * kb], qr[0], negm[0]); s[1][kb] = MF16(kf[2 * kb], qr[2], negm[1]); } \
    _Pragma("unroll") for (int kb = 0; kb < 4; ++kb) { s[0][kb] = MF16(kf[2 * kb + 1], qr[1], s[0][kb]); s[1][kb] = MF16(kf[2 * kb + 1], qr[3], s[1][kb]); } } while (0)
#define VLD16(BUF, vpe, vpo, D0) do { _Pragma("unroll") for (int st = 0; st < 2; ++st) { _Pragma("unroll") for (int dbl = 0; dbl < 2; ++dbl) { const lds_cptr q_ = (dbl ? (vpo) : (vpe)) + ((D0) >> 1) * 8192 + ((D0) & 1) * 4096 + st * 2048; \
      BUF[(2 * st + dbl) * 2] = vtr(q_); BUF[(2 * st + dbl) * 2 + 1] = vtr(q_ + 1024); } } } while (0)
#define VFRG16(BUF, st, dbl) ((bf16x8){BUF[(2 * (st) + (dbl)) * 2][0], BUF[(2 * (st) + (dbl)) * 2][1], BUF[(2 * (st) + (dbl)) * 2][2], BUF[(2 * (st) + (dbl)) * 2][3], BUF[(2 * (st) + (dbl)) * 2 + 1][0], BUF[(2 * (st) + (dbl)) * 2 + 1][1], BUF[(2 * (st) + (dbl)) * 2 + 1][2], BUF[(2 * (st) + (dbl)) * 2 + 1][3]})
#define PVM16(BUF, D0) do { _Pragma("unroll") for (int st = 0; st < 2; ++st) { _Pragma("unroll") for (int dbl = 0; dbl < 2; ++dbl) { \
      o[0][2 * (D0) + dbl] = MF16(VFRG16(BUF, st, dbl), pa[0][st], o[0][2 * (D0) + dbl]); o[1][2 * (D0) + dbl] = MF16(VFRG16(BUF, st, dbl), pa[1][st], o[1][2 * (D0) + dbl]); } } } while (0)
#define LSUM16() do { lacc[0] = MF16(ones, pa[0][0], lacc[0]); lacc[1] = MF16(ones, pa[1][0], lacc[1]); lacc[0] = MF16(ones, pa[0][1], lacc[0]); lacc[1] = MF16(ones, pa[1][1], lacc[1]); } while (0)
  WAIT_BAR();
  KLD16(0); QKM16();
  softmax_seg16<true>(s, mhat, negm, lacc, o, pa);
  if (half) BAR_ONLY();
  int ks_next = KSLOT, vs_cur = 0;
#pragma unroll 1
  for (int j = 0; j < NT - 1; ++j) {
    { const lds_cptr vpe = vpe0 + vs_cur, vpo = vpo0 + vs_cur;
      __builtin_amdgcn_s_setprio(3);
      SBAR();
      KLD16(ks_next); VLD16(va, vpe, vpo, 0); VLD16(vb, vpe, vpo, 1);
      LSUM16();
      QKM16();
      VLD16(vc, vpe, vpo, 2);
      PVM16(va, 0);
      VLD16(va, vpe, vpo, 3);
      PVM16(vb, 1); PVM16(vc, 2); PVM16(va, 3);
      __builtin_amdgcn_sched_group_barrier(0x100, 4, 0);
#pragma unroll
      for (int g_ = 0; g_ < 36; ++g_) { __builtin_amdgcn_sched_group_barrier(0x8, 1, 0); __builtin_amdgcn_sched_group_barrier(0x100, 1, 0); }
#pragma unroll
      for (int g_ = 0; g_ < 16; ++g_) __builtin_amdgcn_sched_group_barrier(0x8, 1, 0);
      SBAR(); }
    __builtin_amdgcn_s_setprio(0);
    WAIT_BAR();
    if (j + 3 < NT) DMA_K(j + 3, (ks_next == KSLOT) ? 0 : ((ks_next == 2 * KSLOT) ? KSLOT : 2 * KSLOT));
    if (j + 2 < NT) DMA_V(j + 2, (vs_cur == 0) ? 2 * VSLOT : vs_cur - VSLOT);
    ks_next = (ks_next == 2 * KSLOT) ? 0 : ks_next + KSLOT; vs_cur = (vs_cur == 2 * VSLOT) ? 0 : vs_cur + VSLOT;
    softmax_seg16<false>(s, mhat, negm, lacc, o, pa);
    LGKM_BAR();
  }
  { const lds_cptr vpe = vpe0 + vs_cur, vpo = vpo0 + vs_cur;
    __builtin_amdgcn_s_setprio(3);
    SBAR(); VLD16(va, vpe, vpo, 0); VLD16(vb, vpe, vpo, 1); LSUM16();
    SBAR(); PVM16(va, 0); VLD16(va, vpe, vpo, 2);
    SBAR(); PVM16(vb, 1); VLD16(vb, vpe, vpo, 3);
    SBAR(); PVM16(va, 2);
    SBAR(); PVM16(vb, 3); SBAR(); __builtin_amdgcn_s_setprio(0); WAIT_BAR(); }
  if (!half) BAR_ONLY();
  l_out[0] = lacc[0][0]; l_out[1] = lacc[1][0];
#undef DMA_K
#undef DMA_V
#undef KLD16
#undef QKM16
#undef VLD16
#undef VFRG16
#undef PVM16
#undef LSUM16
}

constexpr int STG_PITCH = 272;
__device__ __forceinline__ void attn_unit16(int b, int h, int qb_, const bf16_t* Q, const bf16_t* Kall, const bf16_t* Vall, bf16_t* O, const float* subw, float lam, float* stash, char* lds) {
  const int tid = threadIdx.x, wid = tid >> 6, lane = tid & 63, l15 = lane & 15, g = lane >> 4;
  const long qrow0 = (long)b * SEQ + qb_ * 256 + wid * QBLK;
  const bf16_t* Vh = Vall + (long)b * SK * DM + h * 128;
  f32x4a o[2][8]; float l2[2];
#pragma unroll 1
  for (int c = 0; c < 2; ++c) {
    const bf16_t* Qrow = Q + (qrow0 + l15) * DM + h * 128 + c * 64 + g * 8;
    const bf16_t* Kh = Kall + (long)b * SK * DM + h * 128 + c * 64;
    flash_pass16(Qrow, Kh, Vh, lds, o, l2);
#pragma unroll
    for (int qb = 0; qb < 2; ++qb) { const float rl = __builtin_amdgcn_rcpf(l2[qb]);
#pragma unroll
      for (int db = 0; db < 8; ++db) o[qb][db] *= rl; }
    int tt = tid; asm volatile("" : "+v"(tt));
    float* stl = stash + tt;
    if (c == 0) {
#pragma unroll
      for (int qb = 0; qb < 2; ++qb)
#pragma unroll
        for (int db = 0; db < 8; ++db)
#pragma unroll
          for (int i = 0; i < 4; ++i) stl[((qb * 8 + db) * 4 + i) * 512] = o[qb][db][i];
    } else {
      const int ll = tt & 63, l15l = ll & 15, gl = ll >> 4;
      float rs[2];
#pragma unroll
      for (int qb = 0; qb < 2; ++qb) { float ss = 0.f;
#pragma unroll
        for (int db = 0; db < 8; ++db) {
#pragma unroll
          for (int i = 0; i < 4; ++i) { const float v0 = stl[((qb * 8 + db) * 4 + i) * 512] - lam * o[qb][db][i]; o[qb][db][i] = v0; ss += v0 * v0; }
          if ((db & 3) == 3) asm volatile("" ::: "memory"); }
        rs[qb] = rsqrtf(xg_sum(ss) * (1.0f / 128.0f) + EPS) * (1.0f - LAM_INIT); }
      asm volatile("s_waitcnt lgkmcnt(0)" ::: "memory");
      char* stg = lds + (tt >> 6) * (32 * STG_PITCH);
#pragma unroll
      for (int db = 0; db < 8; ++db) { const f32x4a sw = *(const f32x4a*)(subw + 16 * db + 4 * gl);
#pragma unroll
        for (int qb = 0; qb < 2; ++qb) { const f32x4a v = o[qb][db] * rs[qb] * sw;
          unsigned long long w = (unsigned long long)cvtpk(v[0], v[1]) | ((unsigned long long)cvtpk(v[2], v[3]) << 32);
          *(unsigned long long*)(stg + (16 * qb + l15l) * STG_PITCH + 32 * db + 8 * gl) = w; } }
      asm volatile("s_waitcnt lgkmcnt(0)" ::: "memory");
      bf16_t* Ow = O + (qrow0 + (ll >> 4)) * DM + h * 128 + (ll & 15) * 8; const char* srd = stg + (ll >> 4) * STG_PITCH + (ll & 15) * 16;
#pragma unroll
      for (int i = 0; i < 8; ++i) { const u32x4 v = *(const u32x4*)(srd + i * 4 * STG_PITCH); *(u32x4*)(Ow + (long)i * 4 * DM) = v; }
    }
    asm volatile("s_waitcnt vmcnt(0) lgkmcnt(0)\n\ts_barrier" ::: "memory");
  }
}
#undef MF16

__device__ __forceinline__ void attn_unit_mix(int b, int h, int qb_, const bf16_t* Q, const bf16_t* Kall, const bf16_t* Vall, const unsigned char* V8T, const unsigned char* K8, const unsigned char* Q8, bf16_t* O, const float* subw, float lam, float* stash, char* lds) {
  const int tid = threadIdx.x, wid = __builtin_amdgcn_readfirstlane(tid >> 6);
  const long qrow0 = (long)b * SEQ + qb_ * 256 + wid * QBLK;
  const bf16_t* Vh = Vall + (long)b * SK * DM + h * 128;
  {
    int t0 = threadIdx.x; asm volatile("" : "+v"(t0));
    const bf16_t* Qrow = Q + (qrow0 + (t0 & 15)) * DM + h * 128 + ((t0 >> 4) & 3) * 8;
    const bf16_t* Kh = Kall + (long)b * SK * DM + h * 128;
    f32x4a o[2][8]; float l2[2];
    flash_pass16(Qrow, Kh, Vh, lds, o, l2);
#pragma unroll
    for (int qb = 0; qb < 2; ++qb) { const float rl = __builtin_amdgcn_rcpf(l2[qb]);
#pragma unroll
      for (int db = 0; db < 8; ++db) o[qb][db] *= rl; }
    int tt = tid; asm volatile("" : "+v"(tt));
    float* st = stash + (size_t)((tt >> 6) * 32 + (tt & 15)) * 128 + ((tt >> 4) & 3) * 4;
#pragma unroll
    for (int qb = 0; qb < 2; ++qb)
#pragma unroll
      for (int db = 0; db < 8; ++db) *(f32x4a*)(st + qb * 16 * 128 + db * 16) = o[qb][db];
    asm volatile("s_waitcnt vmcnt(0) lgkmcnt(0)\n\ts_barrier" ::: "memory");
  }
  {
    int t1 = threadIdx.x; asm volatile("" : "+v"(t1));
    const int r32 = t1 & 31, hi = (t1 >> 5) & 1;
    float* ws = (float*)(lds + R_WS) + wid * 64;
    f32x16 o[4]; float l_reg;
    flash_pass8(Q8 + ((size_t)(qrow0 + r32) * NH + h) * 64 + hi * 32, K8 + (size_t)(b * NH + h) * NT * 4096, V8T + (size_t)(b * NH + h) * NT * 8192, lds, o, l_reg);
    if (hi == 0) ws[r32] = l_reg; asm volatile("s_waitcnt lgkmcnt(0)" ::: "memory");
    {
#pragma unroll
      for (int r = 0; r < 16; ++r) { const float rl = __builtin_amdgcn_rcpf(ws[crow(r, hi)]);
#pragma unroll
        for (int d0 = 0; d0 < 4; ++d0) o[d0][r] *= rl; }
    }
    int tt = tid; asm volatile("" : "+v"(tt));
    const int ll = tt & 63, r32l = ll & 31, hil = ll >> 5;
    const float* sr = stash + (size_t)((tt >> 6) * 32 + 4 * hil) * 128 + r32l;
    float ss[16];
#pragma unroll
    for (int r = 0; r < 16; ++r) ss[r] = 0.f;
#pragma unroll
    for (int d0 = 0; d0 < 4; ++d0) {
#pragma unroll
      for (int r = 0; r < 16; ++r) { const float v0 = sr[((r & 3) + 8 * (r >> 2)) * 128 + 32 * d0] - lam * o[d0][r]; o[d0][r] = v0; ss[r] += v0 * v0; }
      asm volatile("" ::: "memory"); }
#pragma unroll
    for (int r = 0; r < 16; ++r) { float s = ss[r];
      s += __uint_as_float(__builtin_amdgcn_ds_swizzle(__float_as_uint(s), (1 << 10) | 0x1f)); s += __uint_as_float(__builtin_amdgcn_ds_swizzle(__float_as_uint(s), (2 << 10) | 0x1f));
      s += __uint_as_float(__builtin_amdgcn_ds_swizzle(__float_as_uint(s), (4 << 10) | 0x1f)); s += __uint_as_float(__builtin_amdgcn_ds_swizzle(__float_as_uint(s), (8 << 10) | 0x1f));
      s += __uint_as_float(__builtin_amdgcn_ds_swizzle(__float_as_uint(s), (16 << 10) | 0x1f));
      ss[r] = rsqrtf(s * (1.0f / 128.0f) + EPS) * (1.0f - LAM_INIT); }
    asm volatile("s_waitcnt lgkmcnt(0)" ::: "memory");
    bf16_t* stg = (bf16_t*)(lds + (tt >> 6) * 8192);
    bf16_t* stgl = stg + hil * 4 * 128 + r32l;
#pragma unroll
    for (int d0 = 0; d0 < 4; ++d0) { const float sw = subw[32 * d0 + r32l];
#pragma unroll
      for (int r = 0; r < 16; ++r) { const unsigned w = cvtpk(o[d0][r] * ss[r] * sw, 0.f); stgl[((r & 3) + 8 * (r >> 2)) * 128 + 32 * d0] = (bf16_t)w; } }
    asm volatile("s_waitcnt lgkmcnt(0)" ::: "memory");
    bf16_t* Ow = O + (qrow0 + (ll >> 4)) * DM + h * 128 + (ll & 15) * 8; const bf16_t* srd = stg + (ll >> 4) * 128 + (ll & 15) * 8;
#pragma unroll
    for (int i = 0; i < 8; ++i) { const u32x4 v = *(const u32x4*)(srd + i * 4 * 128); *(u32x4*)(Ow + (long)i * 4 * DM) = v; }
    asm volatile("s_waitcnt vmcnt(0) lgkmcnt(0)\n\ts_barrier" ::: "memory");
  }
}
#undef BAR_ONLY
#undef WAIT_BAR
#undef LGKM_BAR
#undef SBAR
}

constexpr int NWAVES = 8;
constexpr size_t MiB = 1u << 20;
constexpr size_t WS_CTL = 0, CTL_ZERO_BYTES = 1 * MiB;
constexpr size_t WS_MOD = 1 * MiB;
constexpr size_t WS_ROPE = WS_MOD + 256 * 1024;
constexpr size_t WS_WSB = WS_ROPE + 64 * 1024;
constexpr size_t WS_TOKE = 2 * MiB;
constexpr size_t WS_TOKG = WS_TOKE + 256 * 1024;
constexpr size_t WS_CNT = WS_TOKG + 256 * 1024;
constexpr size_t WS_PANE = WS_CNT + 16 * 1024;
constexpr size_t WS_PANV = WS_PANE + 2048;
constexpr size_t WS_NPAN = WS_PANV + 2048;
constexpr size_t WS_TSLOT = 3 * MiB;
constexpr size_t WS_WQKV = 8 * MiB, WS_WO = 14 * MiB, WS_WGU = 16 * MiB, WS_WD = 27 * MiB, WS_WIN = 33 * MiB, WS_WOUT = 41 * MiB;
constexpr size_t WS_MGU = 45 * MiB, WS_MD = 157 * MiB, WS_ACT = 213 * MiB;
constexpr size_t WS_A = WS_ACT;
constexpr size_t WS_Q = WS_A + 65 * MiB, WS_K = WS_Q + 64 * MiB, WS_V = WS_K + 65 * MiB;
constexpr size_t WS_STASH = WS_V + 65 * MiB;
constexpr size_t WS_HID = WS_Q;
constexpr size_t WS_Z = WS_Q;
constexpr size_t WS_V8T = 101 * MiB;
constexpr size_t WS_K8A = 520 * MiB, WS_Q8A = 504 * MiB;
constexpr size_t WS_K8 = 134 * MiB, WS_Q8 = 185 * MiB;
constexpr size_t WS_H8 = 101 * MiB;
constexpr size_t WS_AP8 = WS_A;
constexpr size_t WS_Y = WS_Q + 3 * MiB;
constexpr size_t WS_HM = WS_Y + 136 * MiB;
constexpr size_t HM_BYTES = (size_t)64 * 256 * EXD;
constexpr size_t WS_END = 537 * MiB;
static_assert(WS_HM + 2 * HM_BYTES <= WS_END && WS_V + (size_t)BATCH * SK * DM * 2 <= WS_END, "d_ws map");
constexpr int CW_BAR = 4096;
constexpr int MAX_PANELS = 272, PASS_PANELS = 64;
constexpr int RING_OFF = 0, RING_BYTES = 131072, LDSCTL_OFF = RING_BYTES, MISC_OFF = LDSCTL_OFF + 320, LDS_BYTES = 147456;
static_assert(att::LDS_BYTES <= RING_BYTES, "attention LDS");

#define GAS __attribute__((address_space(1)))
#define LAS __attribute__((address_space(3)))
typedef unsigned short bf16;
typedef unsigned v4u __attribute__((ext_vector_type(4)));
typedef float f32x4 __attribute__((ext_vector_type(4)));
typedef GAS unsigned gu32;
#define RLX_AGENT __ATOMIC_RELAXED, __HIP_MEMORY_SCOPE_AGENT
#define LDS_WAIT() asm volatile("s_waitcnt lgkmcnt(0)" ::: "memory")
#define VM_WAIT() asm volatile("s_waitcnt vmcnt(0)" ::: "memory")
__device__ __forceinline__ unsigned pk2(float lo, float hi) { unsigned r; asm volatile("v_cvt_pk_bf16_f32 %0, %1, %2" : "=v"(r) : "v"(lo), "v"(hi)); return r; }

#define XB_TMO      128
#define XB_XCNT(j)  (256  + 64 * (j))
#define XB_XSUB(j)  (1280 + 64 * (j))
#define XB_XGEN(j)  (2304 + 64 * (j))
#define XB_TOP      3328
#define XB_TOPGEN   3392
#define XCD_BAR_WORDS 3456
#define XB_SPIN_CAP (1u << 22)
__device__ __forceinline__ unsigned xb_ld(unsigned* p)              { return __hip_atomic_load(p, __ATOMIC_RELAXED, __HIP_MEMORY_SCOPE_AGENT); }
__device__ __forceinline__ unsigned xb_add(unsigned* p, unsigned v) { return __hip_atomic_fetch_add(p, v, __ATOMIC_RELAXED, __HIP_MEMORY_SCOPE_AGENT); }
__device__ __forceinline__ unsigned xb_xcc_id() { return (unsigned)__builtin_amdgcn_s_getreg((3 << 11) | 20) & 0xFu; }
#define XB_SPIN(cond, bar) do { unsigned _sp = 0; while (cond) { __builtin_amdgcn_s_sleep(1); \
    if ((++_sp & 255u) == 0u) { if (xb_ld(&(bar)[XB_TMO])) break; if (_sp > XB_SPIN_CAP) { atomicAdd(&(bar)[XB_TMO], 1u); break; } } } } while (0)
struct XcdBarrier { unsigned* bar; unsigned x; volatile LAS unsigned* st; };
__device__ __forceinline__ XcdBarrier xcd_barrier_post(unsigned* bar, volatile LAS unsigned* st) {
    XcdBarrier b; b.bar = bar; b.x = xb_xcc_id(); b.st = st;
    if (threadIdx.x == 0) (void)xb_add(&bar[XB_XCNT(b.x)], 1u);
    return b;
}
__device__ __forceinline__ void xcd_barrier_complete(unsigned* bar, unsigned x, unsigned& nloc, unsigned& nx) {
    const unsigned G = gridDim.x * gridDim.y * gridDim.z;
    unsigned sum, cnt, mine, sp = 0u;
    for (;;) {
        sum = 0u; cnt = 0u; mine = 0u;
#pragma unroll
        for (unsigned j = 0; j < 16; ++j) { const unsigned c = xb_ld(&bar[XB_XCNT(j)]); sum += c; cnt += (c > 0u) ? 1u : 0u; mine = (j == x) ? c : mine; }
        if (sum == G) break;
        __builtin_amdgcn_s_sleep(1);
        if ((++sp & 255u) == 0u) { if (xb_ld(&bar[XB_TMO])) break; if (sp > XB_SPIN_CAP) { atomicAdd(&bar[XB_TMO], 1u); break; } }
    }
    nloc = mine > 0u ? mine : 1u; nx = cnt > 0u ? cnt : 1u;
}
__device__ __forceinline__ void xcd_barrier(const XcdBarrier& b) {
    asm volatile("s_waitcnt vmcnt(0)" ::: "memory");
    __syncthreads();
    if (threadIdx.x == 0) {
        unsigned* bar = b.bar;
        __builtin_amdgcn_s_waitcnt(0);
        unsigned nloc = b.st[0], nx = b.st[1];
        if (nloc == 0u) { xcd_barrier_complete(bar, b.x, nloc, nx); b.st[0] = nloc; b.st[1] = nx; }
        const unsigned old = xb_add(&bar[XB_XSUB(b.x)], 1u);
        const unsigned gen = old / nloc;
        if (old + 1u == (gen + 1u) * nloc) {
            __builtin_amdgcn_fence(__ATOMIC_RELEASE, "agent");
            asm volatile("s_waitcnt vmcnt(0)" ::: "memory");
            const unsigned og = xb_add(&bar[XB_TOP], 1u);
            const unsigned tg = og / nx;
            if (og + 1u == (tg + 1u) * nx) xb_add(&bar[XB_TOPGEN], 1u);
            else XB_SPIN(xb_ld(&bar[XB_TOPGEN]) == tg, bar);
            __builtin_amdgcn_fence(__ATOMIC_ACQUIRE, "agent");
            xb_add(&bar[XB_XGEN(b.x)], 1u);
            asm volatile("s_waitcnt vmcnt(0)" ::: "memory");
        } else {
            XB_SPIN(xb_ld(&bar[XB_XGEN(b.x)]) == gen, bar);
            __builtin_amdgcn_fence(__ATOMIC_ACQUIRE, "agent");
            asm volatile("s_waitcnt vmcnt(0)" ::: "memory");
        }
    }
    __syncthreads();
}

#define DPP_ADD(v, CTRL, ROWMASK) ((v) + __int_as_float(__builtin_amdgcn_update_dpp(0, __float_as_int(v), (CTRL), (ROWMASK), 0xf, false)))
__device__ __forceinline__ float wave_sum(float v) {
    v = DPP_ADD(v, 0xB1, 0xf);
    v = DPP_ADD(v, 0x4E, 0xf);
    v = DPP_ADD(v, 0x141, 0xf);
    v = DPP_ADD(v, 0x140, 0xf);
    v = DPP_ADD(v, 0x142, 0xa);
    v = DPP_ADD(v, 0x143, 0xc);
    return __int_as_float(__builtin_amdgcn_readlane(__float_as_int(v), 63));
}
template <int KIND> __device__ __forceinline__ int dst_row(int n) {
    if (KIND == 0) return n;
    if (KIND == 1) { if (n >= 2048) return n; const int d = n & 63, ax = d >> 5, dd = d & 31, x2 = dd >> 4, f = dd & 15; return (n & ~63) + 8 * (4 * ax + (f >> 2)) + 4 * x2 + (f & 3); }
    if (KIND == 2) return (n >> 7) * 256 + (n & 127);
    return (n >> 7) * 256 + 128 + (n & 127);
}
template <int KIND> __device__ __forceinline__ void transpose_item(const float* W, int K, int N, bf16* WT, LAS float* scr, int item, int lane) {
    const int nblk = N / 32, kb = item / nblk, nb = item % nblk, k0 = 64 * kb, n0 = 32 * nb;
    { float wv[32];
#pragma unroll
      for (int i = 0; i < 32; ++i) wv[i] = W[(size_t)(k0 + 2 * i + (lane >> 5)) * N + n0 + (lane & 31)];
#pragma unroll
      for (int i = 0; i < 32; ++i) scr[(2 * i + (lane >> 5)) * 33 + (lane & 31)] = wv[i]; }
    LDS_WAIT(); asm volatile("" ::: "memory");
    const int c = lane & 7;
#pragma unroll
    for (int j = 0; j < 4; ++j) { const int n = (lane >> 3) + 8 * j; const LAS float* s = scr + (8 * c) * 33 + n;
        v4u o; o.x = pk2(s[0 * 33], s[1 * 33]); o.y = pk2(s[2 * 33], s[3 * 33]); o.z = pk2(s[4 * 33], s[5 * 33]); o.w = pk2(s[6 * 33], s[7 * 33]);
        *(GAS v4u*)(WT + (size_t)dst_row<KIND>(n0 + n) * K + k0 + 8 * c) = o; }
    LDS_WAIT(); asm volatile("" ::: "memory");
}
template <int KIND> __device__ __forceinline__ void transpose_item8(const float* W, int K, int N, unsigned char* WT, float wscale, LAS float* scr, int item, int lane) {
    const int nblk = N / 32, kb = item / nblk, nb = item % nblk, k0 = 64 * kb, n0 = 32 * nb;
    { float wv[32];
#pragma unroll
      for (int i = 0; i < 32; ++i) wv[i] = W[(size_t)(k0 + 2 * i + (lane >> 5)) * N + n0 + (lane & 31)];
#pragma unroll
      for (int i = 0; i < 32; ++i) scr[(2 * i + (lane >> 5)) * 33 + (lane & 31)] = wv[i] * wscale; }
    LDS_WAIT(); asm volatile("" ::: "memory");
    const int c = lane & 7;
#pragma unroll
    for (int j = 0; j < 4; ++j) { const int n = (lane >> 3) + 8 * j; const LAS float* s = scr + (8 * c) * 33 + n;
        int w0 = __builtin_amdgcn_cvt_pk_fp8_f32(s[0 * 33], s[1 * 33], 0, false); w0 = __builtin_amdgcn_cvt_pk_fp8_f32(s[2 * 33], s[3 * 33], w0, true);
        int w1 = __builtin_amdgcn_cvt_pk_fp8_f32(s[4 * 33], s[5 * 33], 0, false); w1 = __builtin_amdgcn_cvt_pk_fp8_f32(s[6 * 33], s[7 * 33], w1, true);
        *(GAS unsigned long long*)(WT + (size_t)dst_row<KIND>(n0 + n) * K + k0 + 8 * c) = (unsigned long long)(unsigned)w0 | ((unsigned long long)(unsigned)w1 << 32); }
    LDS_WAIT(); asm volatile("" ::: "memory");
}
template <int KIND> __device__ __forceinline__ void transpose_item6(const float* W, int K, int N, unsigned char* WT, LAS float* scr, int item, int lane) {
    const int nblk = N / 32, kb = item / nblk, nb = item % nblk, k0 = 64 * kb, n0 = 32 * nb;
    { float wv[32];
#pragma unroll
      for (int i = 0; i < 32; ++i) wv[i] = W[(size_t)(k0 + 2 * i + (lane >> 5)) * N + n0 + (lane & 31)];
#pragma unroll
      for (int i = 0; i < 32; ++i) scr[(2 * i + (lane >> 5)) * 33 + (lane & 31)] = wv[i]; }
    LDS_WAIT(); asm volatile("" ::: "memory");
    const int n = lane & 31, blk = lane >> 5; const LAS float* sp = scr + (32 * blk) * 33 + n;
    pg8::v16f32 x, y; float mx = 0.f;
#pragma unroll
    for (int i = 0; i < 16; ++i) { x[i] = sp[i * 33]; y[i] = sp[(16 + i) * 33]; mx = fmaxf(mx, fmaxf(fabsf(x[i]), fabsf(y[i]))); }
    const pg8::v8i32 ch = pg8::fp6_chunk(x, y, mx);
    const int k = k0 + 32 * blk; unsigned char* dst = WT + (size_t)dst_row<KIND>(n0 + n) * K + (k >> 7) * 128 + ((k >> 5) & 3) * 16;
    *(GAS v4u*)dst = (v4u){(unsigned)ch[0], (unsigned)ch[1], (unsigned)ch[2], (unsigned)ch[3]};
    *(GAS v4u*)(dst + 64) = (v4u){(unsigned)ch[4], (unsigned)ch[5], (unsigned)ch[6], (unsigned)ch[7]};
    LDS_WAIT(); asm volatile("" ::: "memory");
}
struct RowVec { f32x4 v[4]; };
__device__ __forceinline__ RowVec load_vec(const float* p, int lane) { RowVec r; const f32x4* q = (const f32x4*)p + lane;
#pragma unroll
    for (int j = 0; j < 4; ++j) r.v[j] = q[64 * j]; return r; }
__device__ __forceinline__ RowVec norm_row(const float* xrow, const RowVec& wn, int lane) {
    RowVec x = load_vec(xrow, lane); float s = 0.f;
#pragma unroll
    for (int j = 0; j < 4; ++j) s += (x.v[j].x * x.v[j].x + x.v[j].y * x.v[j].y) + (x.v[j].z * x.v[j].z + x.v[j].w * x.v[j].w);
    const float rs = rsqrtf(wave_sum(s) * (1.0f / DM) + EPS);
#pragma unroll
    for (int j = 0; j < 4; ++j) x.v[j] = x.v[j] * rs * wn.v[j];
    return x;
}
__device__ __forceinline__ void store_row_bf16(bf16* orow, const RowVec& y, int lane) {
    GAS unsigned long long* o8 = (GAS unsigned long long*)orow + lane;
#pragma unroll
    for (int j = 0; j < 4; ++j) o8[64 * j] = (unsigned long long)pk2(y.v[j].x, y.v[j].y) | ((unsigned long long)pk2(y.v[j].z, y.v[j].w) << 32);
}

template <bool F8OUT = false> __device__ __forceinline__ void norm_mod_rows(const float* src, bf16* dst, int nrows, int gw, int NGW, const RowVec& wn, const RowVec& sh, const RowVec& sc, int lane) {
    for (int m = gw; m < nrows; m += 4 * NGW) {
        RowVec x[4];
#pragma unroll
        for (int u = 0; u < 4; ++u) { const int r = m + u * NGW; x[u] = load_vec(src + (size_t)(r < nrows ? r : m) * DM, lane); }
#pragma unroll
        for (int u = 0; u < 4; ++u) { const int r = m + u * NGW; if (r < nrows) { float s = 0.f;
#pragma unroll
            for (int j = 0; j < 4; ++j) s += (x[u].v[j].x * x[u].v[j].x + x[u].v[j].y * x[u].v[j].y) + (x[u].v[j].z * x[u].v[j].z + x[u].v[j].w * x[u].v[j].w);
            const float rs = rsqrtf(wave_sum(s) * (1.0f / DM) + EPS);
#pragma unroll
            for (int j = 0; j < 4; ++j) x[u].v[j] = x[u].v[j] * rs * wn.v[j] * (1.0f + sc.v[j]) + sh.v[j];
            if (F8OUT) { unsigned* h8 = (unsigned*)((unsigned char*)dst + (size_t)r * DM) + lane;
#pragma unroll
                for (int j = 0; j < 4; ++j) { int w = __builtin_amdgcn_cvt_pk_fp8_f32(x[u].v[j].x, x[u].v[j].y, 0, false); w = __builtin_amdgcn_cvt_pk_fp8_f32(x[u].v[j].z, x[u].v[j].w, w, true); h8[64 * j] = (unsigned)w; } }
            else store_row_bf16(dst + (size_t)r * DM, x[u], lane); } }
    }
}

struct Args { const float* in[29]; float* out; unsigned char* ws; int ph_lo, ph_hi; };
constexpr int N_PHASES = 25;
constexpr int I_MGU_ = (DM / 64) * (EXD / 32), I_MD_ = (EXD / 64) * (DM / 32), MOE_ITEMS = NE * (2 * I_MGU_ + I_MD_);
__device__ __forceinline__ void moe_weight_item(const Args& args, unsigned char* ws, LAS float* scr, int r, int lane) {
    const int per_e = 2 * I_MGU_ + I_MD_, e = r / per_e; r -= e * per_e;
    if (r < I_MGU_) { transpose_item6<2>(args.in[26] + (size_t)e * DM * EXD, DM, EXD, (unsigned char*)(ws + WS_MGU) + (size_t)e * 2 * EXD * DM, scr, r, lane); return; } r -= I_MGU_;
    if (r < I_MGU_) { transpose_item6<3>(args.in[27] + (size_t)e * DM * EXD, DM, EXD, (unsigned char*)(ws + WS_MGU) + (size_t)e * 2 * EXD * DM, scr, r, lane); return; } r -= I_MGU_;
    transpose_item8<0>(args.in[28] + (size_t)e * EXD * DM, EXD, DM, (unsigned char*)(ws + WS_MD) + (size_t)e * DM * EXD, W8SCALE, scr, r, lane);
}
constexpr int QKV_UNITS = 130 * 12;
__device__ __forceinline__ int moe_tail_items(int G) { const int rem = QKV_UNITS % G, idle = (rem > 0) ? G - rem : 0; const int n = idle * NWAVES * 6; return n < MOE_ITEMS ? n : MOE_ITEMS; }

__global__ void __launch_bounds__(NWAVES * 64, 2) fwd_kernel(Args args) {
    extern __shared__ __attribute__((aligned(16))) unsigned char lds[];
    LAS unsigned char* ldsl = (LAS unsigned char*)lds;
    volatile LAS unsigned* MISC = (volatile LAS unsigned*)(ldsl + MISC_OFF);
    int tid = threadIdx.x, lane = tid & 63; const int wave = __builtin_amdgcn_readfirstlane(tid >> 6);
#define PHASE_BEGIN() asm volatile("" : "+v"(tid), "+v"(lane))
    const int G = gridDim.x, bx = blockIdx.x;
    const int vcu = (G % 8 == 0) ? (bx % 8) * (G / 8) + bx / 8 : bx;
    const int gw = vcu * NWAVES + wave, NGW = G * NWAVES;
    unsigned char* ws = args.ws;
    gu32* ctl = (gu32*)(ws + WS_CTL);
    for (int u = tid; u < (LDS_BYTES - LDSCTL_OFF) / 4; u += NWAVES * 64) ((LAS unsigned*)(ldsl + LDSCTL_OFF))[u] = 0u;
    __syncthreads();
    XcdBarrier bar; bar.bar = (unsigned*)(ctl + CW_BAR); bar.x = 0; bar.st = nullptr;
    if (MK_N_LAUNCHES == 1) bar = xcd_barrier_post((unsigned*)(ctl + CW_BAR), MISC + 8);
    const int lo = args.ph_lo, hi = args.ph_hi;
#ifndef PH_MASK
#define PH_MASK 0xffffffffu
#endif
#define IN(k) (((PH_MASK >> (k)) & 1u) && lo <= (k) && (k) < hi)
#define GRID_BAR() do { if (MK_N_LAUNCHES == 1) xcd_barrier(bar); } while (0)
    const float* x_in = args.in[0]; const float* c_in = args.in[1]; const float* ctx_in = args.in[2]; const float* cctx_in = args.in[3];
    const float* w_mod = args.in[4]; const float* b_mod = args.in[5]; const float* norm1_w = args.in[6]; const float* norm2_w = args.in[7]; const float* final_w = args.in[8];
    float* xres = args.out;
    float* MOD = (float*)(ws + WS_MOD); float* ROPE = (float*)(ws + WS_ROPE);
    bf16* ABUF = (bf16*)(ws + WS_A);
#define MODP(l, cond, chunk) (MOD + ((size_t)((l) * 3 + (cond)) * 6144 + (chunk) * 1024))

    if (IN(0)) { PHASE_BEGIN();
        if (vcu < 48) {
            const int l = vcu / 24, cb = vcu % 24;
            LAS float* sl = (LAS float*)(ldsl + RING_OFF);
            LAS float* red = sl + 3 * 1024;
            for (int i = tid; i < 3 * 1024; i += NWAVES * 64) { const int cd = i >> 10, k = i & 1023; const float v = cd < 2 ? c_in[cd * 1024 + k] : cctx_in[k]; sl[i] = v / (1.0f + __expf(-v)); }
            __syncthreads();
            f32x4 a0 = {0, 0, 0, 0}, a1 = a0, a2 = a0;
            const float* wp = w_mod + ((size_t)l * 1024 + wave * 128) * 6144 + cb * 256 + lane * 4;
#pragma unroll 16
            for (int k = 0; k < 128; ++k) { const f32x4 w = *(const f32x4*)(wp + (size_t)k * 6144); const int kk = wave * 128 + k; a0 += w * sl[kk]; a1 += w * sl[1024 + kk]; a2 += w * sl[2048 + kk]; }
            *(LAS f32x4*)(red + (wave * 3 + 0) * 256 + lane * 4) = a0; *(LAS f32x4*)(red + (wave * 3 + 1) * 256 + lane * 4) = a1; *(LAS f32x4*)(red + (wave * 3 + 2) * 256 + lane * 4) = a2;
            __syncthreads();
            for (int i = tid; i < 3 * 256; i += NWAVES * 64) { const int cd = i >> 8, cc = i & 255; float s = 0.f;
#pragma unroll
                for (int w = 0; w < 8; ++w) s += red[(w * 3 + cd) * 256 + cc];
                MOD[(size_t)(l * 3 + cd) * 6144 + cb * 256 + cc] = s + b_mod[l * 6144 + cb * 256 + cc]; }
            __syncthreads();
        } else if (vcu == 48) {
            for (int i = tid; i < 4096; i += NWAVES * 64) { const int pos = i >> 4, f = i & 15; const float inv = powf(10000.0f, -(float)f / 16.0f); const float ang = (float)pos * inv; ROPE[i] = cosf(ang); ROPE[4096 + i] = sinf(ang); }
        } else if (vcu == 49) {
            const float* wsrc = args.in[19]; bf16* wd = (bf16*)(ws + WS_WSB);
            for (int i = tid; i < 8 * 128 * 128 / 2; i += NWAVES * 64) ((unsigned*)wd)[i] = pk2(wsrc[2 * i], wsrc[2 * i + 1]);
        }
        LAS float* scr = (LAS float*)(ldsl + RING_OFF + 32768 + wave * 8704);
        {
            constexpr int I_QKV = (DM / 64) * (3072 / 32), I_O = (DM / 64) * (DM / 32), I_GU = (DM / 64) * (FFN / 32), I_D = (FFN / 64) * (DM / 32);
            constexpr int I_IN = (DM / 64) * (4096 / 32), I_OUT = (GMH / 64) * (DM / 32), I_MGU = (DM / 64) * (EXD / 32), I_MD = (EXD / 64) * (DM / 32);
            constexpr int NITEMS = I_QKV + I_O + 2 * I_GU + I_D + I_IN + I_OUT + NE * (2 * I_MGU + I_MD);
            const int nitems0 = NITEMS - moe_tail_items(G);
            for (int it = gw; it < nitems0; it += NGW) {
                int r = it;
                if (r < I_QKV) { if (QKV_F8) transpose_item8<1>(args.in[9], DM, 3072, (unsigned char*)(ws + WS_WQKV), W8SCALE, scr, r, lane); else transpose_item<1>(args.in[9], DM, 3072, (bf16*)(ws + WS_WQKV), scr, r, lane); continue; } r -= I_QKV;
                if (r < I_O) { transpose_item<0>(args.in[10], DM, DM, (bf16*)(ws + WS_WO), scr, r, lane); continue; } r -= I_O;
                if (r < I_GU) { transpose_item<2>(args.in[22], DM, FFN, (bf16*)(ws + WS_WGU), scr, r, lane); continue; } r -= I_GU;
                if (r < I_GU) { transpose_item<3>(args.in[23], DM, FFN, (bf16*)(ws + WS_WGU), scr, r, lane); continue; } r -= I_GU;
                if (r < I_D) { transpose_item<0>(args.in[24], FFN, DM, (bf16*)(ws + WS_WD), scr, r, lane); continue; } r -= I_D;
                if (r < I_IN) { transpose_item<0>(args.in[16], DM, 4096, (bf16*)(ws + WS_WIN), scr, r, lane); continue; } r -= I_IN;
                if (r < I_OUT) { transpose_item<0>(args.in[21], GMH, DM, (bf16*)(ws + WS_WOUT), scr, r, lane); continue; } r -= I_OUT;
                moe_weight_item(args, ws, scr, r, lane);
            }
        }
        GRID_BAR();
    }

    if (IN(1)) { PHASE_BEGIN();
        const RowVec wn = load_vec(norm1_w, lane);
        for (int b = 0; b < 3; ++b) {
            const RowVec sh = load_vec(MODP(0, b, 0), lane), sc = load_vec(MODP(0, b, 1), lane);
            const int nrows = b < 2 ? SEQ : BATCH * CTXL; const float* src = b < 2 ? x_in + (size_t)b * SEQ * DM : ctx_in; bf16* dst = ABUF + (size_t)(b < 2 ? b * SEQ : T) * DM;
            if (QKV_F8) norm_mod_rows<true>(src, (bf16*)((unsigned char*)ABUF + (size_t)(b < 2 ? b * SEQ : T) * DM), nrows, gw, NGW, wn, sh, sc, lane);
            else norm_mod_rows(src, dst, nrows, gw, NGW, wn, sh, sc, lane);
        }
        GRID_BAR();
    }

    if (IN(2)) { PHASE_BEGIN();
        pg8::StaticOrder S; S.init(130, 12, G, bx);
        pg8::EpiQKV E{(bf16*)(ws + WS_Q), (bf16*)(ws + WS_K), (bf16*)(ws + WS_V), ROPE, ROPE + 4096, QKV_F8 ? 1.0f / W8SCALE : 1.0f};
        if (QKV_F8) { pg8::Gemm g{ABUF, (const bf16*)(ws + WS_WQKV), DM / 2, DM / 2, DM / 2}; pg8::gemm_phase<pg8::EpiQKV, pg8::StaticOrder, 1>(ldsl + RING_OFF, g, S, E); }
        else { pg8::Gemm g{ABUF, (const bf16*)(ws + WS_WQKV), DM, DM, DM}; pg8::gemm_phase(ldsl + RING_OFF, g, S, E); }
        { const int rem = QKV_UNITS % G, tailn = moe_tail_items(G);
          if (tailn > 0 && bx >= rem) { LAS float* scr = (LAS float*)(ldsl + RING_OFF + 32768 + wave * 8704);
              for (int r = MOE_ITEMS - tailn + (bx - rem) * NWAVES + wave; r < MOE_ITEMS; r += (G - rem) * NWAVES) moe_weight_item(args, ws, scr, r, lane); } }
        GRID_BAR();
    }

    if (IN(3)) { PHASE_BEGIN();
        float lam;
        { const float a = args.in[11][lane] * args.in[12][lane], b2 = args.in[13][lane] * args.in[14][lane]; lam = __expf(wave_sum(a)) - __expf(wave_sum(b2)) + LAM_INIT; }
        const float* subw = args.in[15];
        { const bf16* Vall = (const bf16*)(ws + WS_V); unsigned char* V8T = (unsigned char*)(ws + WS_V8T);
          for (int it = gw; it < BATCH * NH * att::NT; it += NGW) {
              const int b = it / (NH * att::NT), rem = it - b * NH * att::NT, h = rem / att::NT, t = rem - h * att::NT;
              const bf16* src = Vall + ((size_t)b * SK + (size_t)t * 64) * DM + h * 128 + 2 * lane;
              unsigned w[64];
#pragma unroll
              for (int k = 0; k < 64; ++k) w[k] = *(const unsigned*)(src + (size_t)k * DM);
              unsigned char* dstt = V8T + (size_t)it * 8192;
#pragma unroll
              for (int dd = 0; dd < 2; ++dd) { const int d = 2 * lane + dd, sd = (d >> 2) & 3;
#pragma unroll
                  for (int c = 0; c < 4; ++c) { v4u o4;
#pragma unroll
                      for (int wq = 0; wq < 4; ++wq) { const int k0 = 32 * (c & 1) + 8 * wq + 4 * (c >> 1);
                          const float v0 = dd ? att::bf_hi(w[k0]) : att::bf_lo(w[k0]), v1 = dd ? att::bf_hi(w[k0 + 1]) : att::bf_lo(w[k0 + 1]), v2 = dd ? att::bf_hi(w[k0 + 2]) : att::bf_lo(w[k0 + 2]), v3 = dd ? att::bf_hi(w[k0 + 3]) : att::bf_lo(w[k0 + 3]);
                          int a = __builtin_amdgcn_cvt_pk_fp8_f32(v0, v1, 0, false); a = __builtin_amdgcn_cvt_pk_fp8_f32(v2, v3, a, true); o4[wq] = (unsigned)a; }
                      *(v4u*)(dstt + d * 64 + ((c ^ sd) * 16)) = o4; } }
          } }
        for (int cs = 0; cs < 2; ++cs)
        { const bf16* Kall = (const bf16*)(ws + WS_K); unsigned char* K8 = (unsigned char*)(ws + (cs ? WS_K8 : WS_K8A));
          for (int it = gw; it < BATCH * NH * att::NT; it += NGW) {
              const int b = it / (NH * att::NT), rem = it - b * NH * att::NT, h = rem / att::NT, t = rem - h * att::NT;
              const v4u* src = (const v4u*)(Kall + ((size_t)b * SK + (size_t)t * 64 + lane) * DM + h * 128 + cs * 64);
              v4u w8[8];
#pragma unroll
              for (int k = 0; k < 8; ++k) w8[k] = src[k];
              unsigned char* dstt = K8 + (size_t)it * 4096 + lane * 64; const int sd = (lane >> 2) & 3;
#pragma unroll
              for (int hh = 0; hh < 2; ++hh) {
                  pg8::v16f32 xe, xo; float mx = 0.f;
#pragma unroll
                  for (int i = 0; i < 16; ++i) { const unsigned w = w8[(16 * hh + i) >> 2][(16 * hh + i) & 3]; xe[i] = att::bf_lo(w); xo[i] = att::bf_hi(w); mx = fmaxf(mx, fmaxf(fabsf(xe[i]), fabsf(xo[i]))); }
                  const pg8::v8i32 c8 = pg8::fp6_chunk(xe, xo, mx);
                  *(v4u*)(dstt + (((2 * hh) ^ sd) * 16)) = (v4u){(unsigned)c8[0], (unsigned)c8[1], (unsigned)c8[2], (unsigned)c8[3]};
                  *(v4u*)(dstt + (((2 * hh + 1) ^ sd) * 16)) = (v4u){(unsigned)c8[4], (unsigned)c8[5], (unsigned)c8[6], (unsigned)c8[7]}; } }
        }
        GRID_BAR();
        for (int i = 0; i < 4; ++i) {
            const int bh = (vcu >> 5) * 2 + (i >> 1), qb = (vcu & 31) * 2 + (i & 1);
            att::attn_unit_88(bh >> 3, bh & 7, qb, (const bf16*)(ws + WS_V), (const unsigned char*)(ws + WS_V8T), (const unsigned char*)(ws + WS_K8A), (const unsigned char*)(ws + WS_K8), (const unsigned char*)(ws + WS_Q), (const unsigned char*)(ws + WS_Q), ABUF, subw, lam, (float*)(ws + WS_STASH) + (size_t)bx * 64 * 512, (char*)lds + RING_OFF);
        }
        GRID_BAR();
    }

    if (IN(4)) { PHASE_BEGIN();
        pg8::Gemm g{ABUF, (const bf16*)(ws + WS_WO), DM, DM, DM}; pg8::StaticOrder S; S.init(128, 4, G, bx);
        pg8::EpiRes E{x_in, xres, MODP(0, 0, 2), 6144};
        pg8::gemm_phase(ldsl + RING_OFF, g, S, E);
        GRID_BAR();
    }
    if (IN(5)) { PHASE_BEGIN();
        const RowVec wn = load_vec(norm2_w, lane);
        for (int b = 0; b < 2; ++b) {
            const RowVec sh = load_vec(MODP(0, b, 3), lane), sc = load_vec(MODP(0, b, 4), lane);
            norm_mod_rows(xres + (size_t)b * SEQ * DM, ABUF + (size_t)b * SEQ * DM, SEQ, gw, NGW, wn, sh, sc, lane);
        }
        GRID_BAR();
    }
    if (IN(6)) { PHASE_BEGIN();
        pg8::Gemm g{ABUF, (const bf16*)(ws + WS_WGU), DM, DM, DM}; pg8::StaticOrder S; S.init(128, 22, G, bx);
        pg8::EpiSwiGLU E{(bf16*)(ws + WS_HID), FFN, 0, 1.0f, 1.0f};
        pg8::gemm_phase(ldsl + RING_OFF, g, S, E);
        GRID_BAR();
    }
    if (IN(7)) { PHASE_BEGIN();
        pg8::Gemm g{(const bf16*)(ws + WS_HID), (const bf16*)(ws + WS_WD), FFN, FFN, FFN}; pg8::StaticOrder S; S.init(128, 4, G, bx);
        pg8::EpiRes E{xres, xres, MODP(0, 0, 5), 6144};
        pg8::gemm_phase(ldsl + RING_OFF, g, S, E);
        GRID_BAR();
    }
    if (IN(8)) { PHASE_BEGIN();
        const RowVec wn = load_vec(norm1_w + DM, lane);
        for (int b = 0; b < 2; ++b) {
            const RowVec sh = load_vec(MODP(1, b, 0), lane), sc = load_vec(MODP(1, b, 1), lane);
            norm_mod_rows(xres + (size_t)b * SEQ * DM, ABUF + (size_t)b * SEQ * DM, SEQ, gw, NGW, wn, sh, sc, lane);
        }
        GRID_BAR();
    }
    if (IN(9)) { PHASE_BEGIN();
        pg8::Gemm g{ABUF, (const bf16*)(ws + WS_WIN), DM, DM, DM}; pg8::StaticOrder S; S.init(128, 16, G, bx);
        pg8::EpiGelu E{(bf16*)(ws + WS_Z), 4096};
        pg8::gemm_phase(ldsl + RING_OFF, g, S, E);
        GRID_BAR();
    }
    if (IN(10)) { PHASE_BEGIN();
        using att::bf16x8; using att::f32x16;
        bf16* Z = (bf16*)(ws + WS_Z); const bf16* WSB = (const bf16*)(ws + WS_WSB);
        const float* vnw = args.in[17]; const float* vnb = args.in[18]; const float* bs = args.in[20];
        LAS float* stat = (LAS float*)(ldsl + 132096);
        char* Vl = (char*)lds + RING_OFF;
        bf16* Sl = (bf16*)((char*)lds + RING_OFF + 65536);
        const int r32 = lane & 31, hi = lane >> 5;
        const int cc = (tid & 31) * 8, q0 = tid >> 5;
        for (int ck = vcu; ck < T / 128; ck += G) {
            const size_t m0 = (size_t)ck * 128;
            v4u vr[8], ur[8];
            char* zc = (char*)(Z + m0 * 4096);
            const unsigned toff = (unsigned)(q0 * 4096 + cc) * 2u;
#define ZT(i, colb) (*(v4u*)(zc + (size_t)((i) * 16 * 4096 * 2 + (colb)) + toff))
#pragma unroll
            for (int i = 0; i < 8; ++i) vr[i] = ZT(i, 4096);
            for (int i0 = 0; i0 < 16; i0 += 4) {
                v4u wq[4][4];
#pragma unroll
                for (int u = 0; u < 4; ++u) { const bf16* vrow = Z + (m0 + wave * 16 + i0 + u) * 4096 + 2048;
#pragma unroll
                    for (int j = 0; j < 4; ++j) wq[u][j] = *(const v4u*)(vrow + j * 512 + lane * 8); }
#pragma unroll
                for (int u = 0; u < 4; ++u) { const int q = wave * 16 + i0 + u;
                    float xv[32]; float s = 0.f;
#pragma unroll
                    for (int j = 0; j < 4; ++j) {
#pragma unroll
                        for (int k = 0; k < 4; ++k) { xv[j * 8 + 2 * k] = att::bf_lo(wq[u][j][k]); xv[j * 8 + 2 * k + 1] = att::bf_hi(wq[u][j][k]); } }
#pragma unroll
                    for (int k = 0; k < 32; ++k) s += xv[k];
                    const float mean = wave_sum(s) * (1.0f / 2048.0f); float s2 = 0.f;
#pragma unroll
                    for (int k = 0; k < 32; ++k) { const float d = xv[k] - mean; s2 += d * d; }
                    const float rstd = rsqrtf(wave_sum(s2) * (1.0f / 2048.0f) + EPS);
                    if (lane == 0) { stat[q] = mean; stat[128 + q] = rstd; } } }
            __syncthreads();
            const int pw = (wave & 3) * 32, chf = wave >> 2;
            for (int gI = 0; gI < 8; ++gI) {
                { const int cg = gI * 256 + cc;
                  const f32x4 w0 = *(const f32x4*)(vnw + cg), w1 = *(const f32x4*)(vnw + cg + 4), b0 = *(const f32x4*)(vnb + cg), b1 = *(const f32x4*)(vnb + cg + 4);
#pragma unroll
                  for (int i = 0; i < 8; ++i) { const int q = q0 + 16 * i; const v4u w = vr[i]; const float mean = stat[q], rstd = stat[128 + q];
                      float xv[8];
#pragma unroll
                      for (int k = 0; k < 4; ++k) { xv[2 * k] = att::bf_lo(w[k]); xv[2 * k + 1] = att::bf_hi(w[k]); }
                      v4u o; o.x = pk2((xv[0] - mean) * rstd * w0[0] + b0[0], (xv[1] - mean) * rstd * w0[1] + b0[1]); o.y = pk2((xv[2] - mean) * rstd * w0[2] + b0[2], (xv[3] - mean) * rstd * w0[3] + b0[3]);
                      o.z = pk2((xv[4] - mean) * rstd * w1[0] + b1[0], (xv[5] - mean) * rstd * w1[1] + b1[1]); o.w = pk2((xv[6] - mean) * rstd * w1[2] + b1[2], (xv[7] - mean) * rstd * w1[3] + b1[3]);
                      *(v4u*)(Vl + ((q >> 6) * 2 + (cc >> 7)) * 16384 + att::v_st(q & 63, cc & 127)) = o; } }
                bf16x8 wa[8];
#pragma unroll
                for (int ks = 0; ks < 8; ++ks) wa[ks] = *(const bf16x8*)(WSB + ((size_t)gI * 128 + pw + r32) * 128 + ks * 16 + hi * 8);
                __syncthreads();
                if (gI < 7) {
#pragma unroll
                    for (int i = 0; i < 8; ++i) vr[i] = ZT(i, 4096 + (gI + 1) * 512); }
#pragma unroll
                for (int i = 0; i < 8; ++i) ur[i] = ZT(i, gI * 512);
                f32x16 o[4];
#pragma unroll
                for (int d = 0; d < 4; ++d) o[d] = f32x16{};
                const int vb = (int)(uintptr_t)(Vl + chf * 16384) + att::v_rd_base(lane);
                att::pv_d0(o, vb, wa[0], wa[1], wa[2], wa[3]);
                att::pv_d0(o, vb + 32768, wa[4], wa[5], wa[6], wa[7]);
#pragma unroll
                for (int r = 0; r < 16; ++r) { const int p = pw + att::crow(r, hi); const float bsv = bs[gI * 128 + p]; bf16* sp = Sl + p * 256 + chf * 128 + r32;
#pragma unroll
                    for (int d0 = 0; d0 < 4; ++d0) sp[32 * d0] = (bf16)pk2(o[d0][r] + bsv, 0.f); }
                __syncthreads();
#pragma unroll
                for (int i = 0; i < 8; ++i) { const int q = q0 + 16 * i; const v4u sv = *(const v4u*)(Sl + q * 256 + cc); const v4u uv = ur[i]; v4u ov;
#pragma unroll
                    for (int k = 0; k < 4; ++k) ov[k] = pk2(att::bf_lo(uv[k]) * att::bf_lo(sv[k]), att::bf_hi(uv[k]) * att::bf_hi(sv[k]));
                    ZT(i, gI * 512) = ov; }
            }
#undef ZT
            __syncthreads();
        }
        GRID_BAR();
    }
    if (IN(11)) { PHASE_BEGIN();
        pg8::Gemm g{(const bf16*)(ws + WS_Z), (const bf16*)(ws + WS_WOUT), 4096, GMH, GMH}; pg8::StaticOrder S; S.init(128, 4, G, bx);
        pg8::EpiRes E{xres, xres, MODP(1, 0, 2), 6144};
        pg8::gemm_phase(ldsl + RING_OFF, g, S, E);
        GRID_BAR();
    }
    int* TOKE = (int*)(ws + WS_TOKE); float* TOKG = (float*)(ws + WS_TOKG); int* CNT = (int*)(ws + WS_CNT);
    int* PANE = (int*)(ws + WS_PANE); int* PANV = (int*)(ws + WS_PANV); int* NPAN = (int*)(ws + WS_NPAN);
    int* TSLOT = (int*)(ws + WS_TSLOT);
    constexpr int TPW = T / 256;
    if (IN(12)) { PHASE_BEGIN();
        LAS int* lcnt = (LAS int*)(ldsl + RING_OFF);
        if (tid < 16) lcnt[tid] = 0;
        __syncthreads();
        const RowVec wn = load_vec(norm2_w + DM, lane);
        const float* wr_ = args.in[25];
        f32x4 wra[16], wrb[16];
#pragma unroll
        for (int j = 0; j < 4; ++j)
#pragma unroll
            for (int k = 0; k < 4; ++k) { const float* wp = wr_ + (size_t)(256 * j + 4 * lane + k) * 8; wra[4 * j + k] = *(const f32x4*)wp; wrb[4 * j + k] = *(const f32x4*)(wp + 4); }
        for (int ch = vcu; ch < T / TPW; ch += G) {
            const int b = (ch * TPW) >> 14;
            const RowVec sh = load_vec(MODP(1, b, 3), lane), sc = load_vec(MODP(1, b, 4), lane);
            for (int i0 = wave; i0 < TPW; i0 += 2 * NWAVES) {
                RowVec yy[2];
#pragma unroll
                for (int u = 0; u < 2; ++u) yy[u] = load_vec(xres + ((size_t)ch * TPW + i0 + u * NWAVES) * DM, lane);
#pragma unroll
                for (int u = 0; u < 2; ++u) { const size_t row = (size_t)ch * TPW + i0 + u * NWAVES; RowVec& y = yy[u]; float ssq = 0.f;
#pragma unroll
                    for (int j = 0; j < 4; ++j) ssq += (y.v[j].x * y.v[j].x + y.v[j].y * y.v[j].y) + (y.v[j].z * y.v[j].z + y.v[j].w * y.v[j].w);
                    const float rs = rsqrtf(wave_sum(ssq) * (1.0f / DM) + EPS);
#pragma unroll
                    for (int j = 0; j < 4; ++j) y.v[j] = y.v[j] * rs * wn.v[j] * (1.0f + sc.v[j]) + sh.v[j];
                    { LAS f32x4* st = (LAS f32x4*)(ldsl + RING_OFF + 1024 + wave * 9216 + (u * 32 + (lane >> 3)) * 144 + (lane & 7) * 16);
#pragma unroll
                      for (int j = 0; j < 4; ++j) st[j * 8 * 9] = y.v[j]; }
                    float lg[8];
#pragma unroll
                    for (int e = 0; e < 8; ++e) lg[e] = 0.f;
#pragma unroll
                    for (int j = 0; j < 4; ++j)
#pragma unroll
                        for (int k = 0; k < 4; ++k) { const f32x4 wa = wra[4 * j + k], wb = wrb[4 * j + k]; const float yv = y.v[j][k];
                            lg[0] += yv * wa[0]; lg[1] += yv * wa[1]; lg[2] += yv * wa[2]; lg[3] += yv * wa[3]; lg[4] += yv * wb[0]; lg[5] += yv * wb[1]; lg[6] += yv * wb[2]; lg[7] += yv * wb[3]; }
#pragma unroll
                    for (int e = 0; e < 8; ++e) lg[e] = wave_sum(lg[e]);
                    int e1 = 0; float v1 = lg[0];
#pragma unroll
                    for (int e = 1; e < 8; ++e) if (lg[e] > v1) { v1 = lg[e]; e1 = e; }
                    int e2 = -1; float v2 = -INFINITY;
#pragma unroll
                    for (int e = 0; e < 8; ++e) if (e != e1 && lg[e] > v2) { v2 = lg[e]; e2 = e; }
                    const float ex = __expf(v2 - v1), g1v = 1.0f / (1.0f + ex), g2v = ex * g1v;
                    if (lane == 0) { TOKE[row * 2] = e1; TOKE[row * 2 + 1] = e2; TOKG[row * 2] = g1v; TOKG[row * 2 + 1] = g2v; atomicAdd((int*)&lcnt[e1], 1); atomicAdd((int*)&lcnt[8 + e2], 1); }
                }
                { LDS_WAIT(); asm volatile("" ::: "memory");
                  const int u = lane >> 5, blk = lane & 31; const LAS f32x4* sp = (const LAS f32x4*)(ldsl + RING_OFF + 1024 + wave * 9216 + (u * 32 + blk) * 144);
                  pg8::v16f32 x, y; float mx = 0.f;
#pragma unroll
                  for (int q = 0; q < 4; ++q) { const f32x4 a = sp[q], b2 = sp[4 + q];
#pragma unroll
                      for (int k = 0; k < 4; ++k) { x[4 * q + k] = a[k]; y[4 * q + k] = b2[k]; mx = fmaxf(mx, fmaxf(fabsf(a[k]), fabsf(b2[k]))); } }
                  const pg8::v8i32 c8 = pg8::fp6_chunk(x, y, mx);
                  unsigned char* dst = (unsigned char*)(ws + WS_H8) + ((size_t)ch * TPW + i0 + u * NWAVES) * DM + (blk >> 2) * 128 + (blk & 3) * 16;
                  *(v4u*)dst = (v4u){(unsigned)c8[0], (unsigned)c8[1], (unsigned)c8[2], (unsigned)c8[3]};
                  *(v4u*)(dst + 64) = (v4u){(unsigned)c8[4], (unsigned)c8[5], (unsigned)c8[6], (unsigned)c8[7]};
                  LDS_WAIT(); asm volatile("" ::: "memory"); }
            }
            __syncthreads();
            if (tid < 16) { CNT[ch * 16 + tid] = lcnt[tid]; lcnt[tid] = 0; }
            __syncthreads();
        }
        GRID_BAR();
    }
    if (IN(13)) { PHASE_BEGIN();
        LAS int* sb = (LAS int*)(ldsl + RING_OFF);
        for (int ch = vcu; ch < T / TPW; ch += G) {
            if (wave == 0) {
                const int ke = lane & 15, qt = lane >> 4; int tot = 0, pre = 0;
                for (int c0 = qt * 64; c0 < qt * 64 + 64; c0 += 16) { int cv[16];
#pragma unroll
                    for (int u = 0; u < 16; ++u) cv[u] = CNT[(c0 + u) * 16 + ke];
#pragma unroll
                    for (int u = 0; u < 16; ++u) { tot += cv[u]; pre += (c0 + u < ch) ? cv[u] : 0; } }
                tot += __shfl_xor(tot, 16); tot += __shfl_xor(tot, 32); pre += __shfl_xor(pre, 16); pre += __shfl_xor(pre, 32);
                const int pad = (tot + 255) & ~255; int scan = 0;
#pragma unroll
                for (int e = 0; e < 8; ++e) { const int pe = __shfl(pad, (ke & 8) + e); scan += (e < (ke & 7)) ? pe : 0; }
                int reg0 = 0;
#pragma unroll
                for (int e = 0; e < 8; ++e) reg0 += __shfl(pad, e);
                const int rb = (ke >> 3) ? reg0 : 0;
                if (lane < 16) { sb[ke] = rb + scan + pre; sb[16 + ke] = tot; sb[32 + ke] = (rb + scan) >> 8; }
            }
            __syncthreads();
            if (ch == 0 && wave == 1) {
                for (int p = lane; p < MAX_PANELS; p += 64) { int ex = -1;
#pragma unroll
                    for (int ke = 0; ke < 16; ++ke) { const int pb = sb[32 + ke], np = (sb[16 + ke] + 255) >> 8; if (p >= pb && p < pb + np) ex = ke & 7; }
                    PANE[p] = ex; }
                if (lane == 0) NPAN[0] = sb[32 + 15] + ((sb[16 + 15] + 255) >> 8);
            }
            if (wave == 0) {
#pragma unroll
                for (int k = 0; k < 2; ++k) {
                    int run[8];
#pragma unroll
                    for (int e = 0; e < 8; ++e) run[e] = 0;
#pragma unroll
                    for (int half = 0; half < 2; ++half) { const int tok = ch * TPW + half * 64 + lane; const int e = TOKE[tok * 2 + k]; int rank = 0, base = 0;
#pragma unroll
                        for (int ee = 0; ee < 8; ++ee) { const unsigned long long mk = __ballot(e == ee); if (e == ee) { rank = run[ee] + __popcll(mk & ((1ull << lane) - 1ull)); base = sb[k * 8 + ee]; } run[ee] += __popcll(mk); }
                        const int slot = base + rank; TSLOT[tok * 2 + k] = slot;
                        ((LAS int*)(ldsl + RING_OFF + 1024))[k * 128 + half * 64 + lane] = slot; }
                }
            }
            __syncthreads();
            const LAS int* sl = (const LAS int*)(ldsl + RING_OFF + 1024);
            for (int i0 = wave; i0 < 2 * TPW; i0 += 8 * NWAVES) {
                v4u rowv[8]; int slot8[8];
#pragma unroll
                for (int u = 0; u < 8; ++u) { const int i = i0 + u * NWAVES, k = i >> 7, tl = i & 127; slot8[u] = sl[k * 128 + tl];
                    rowv[u] = ((const v4u*)((const unsigned char*)(ws + WS_H8) + ((size_t)ch * TPW + tl) * DM))[lane]; }
#pragma unroll
                for (int u = 0; u < 8; ++u) ((v4u*)((unsigned char*)(ws + WS_AP8) + (size_t)slot8[u] * DM))[lane] = rowv[u]; }
            __syncthreads();
        }
        GRID_BAR();
    }
#define MOE_PASS(PASS) int rS = NPAN[0] - 4 * PASS_PANELS; rS = rS < 0 ? 0 : (rS > PASS_PANELS ? PASS_PANELS : rS); const int p0 = (PASS) == 0 ? 0 : rS + ((PASS) - 1) * PASS_PANELS; \
        int nM = (PASS) == 0 ? rS : NPAN[0] - p0; nM = nM < 0 ? 0 : (nM > PASS_PANELS ? PASS_PANELS : nM);
#define MOE_GU(PASS) do { MOE_PASS(PASS) \
        pg8::Gemm g{(const bf16*)(ws + WS_AP8), (const bf16*)(ws + WS_MGU), DM / 2, DM / 2, DM / 2}; pg8::MoeOrder S; S.init(nM, 28, G, bx, p0, PANE, true, (PASS) == 1 ? rS * 4 : 0, 4); \
        pg8::EpiSwiGLUT<true> E{(bf16*)(ws + WS_HM + ((PASS) & 1) * HM_BYTES), EXD, p0, 1.0f, H8SCALE}; \
        pg8::gemm_phase<pg8::EpiSwiGLUT<true>, pg8::MoeOrder, 2>(ldsl + RING_OFF, g, S, E); } while (0)
#define MOE_DN(PASS) do { MOE_PASS(PASS) \
        pg8::Gemm g{(const bf16*)(ws + WS_HM + ((PASS) & 1) * HM_BYTES), (const bf16*)(ws + WS_MD), EXD / 2, EXD / 2, EXD / 2}; pg8::MoeOrder S; S.init(nM, 4, G, bx, p0, PANE, false); \
        pg8::EpiStore E{(bf16*)(ws + WS_Y), DM, p0, 1.0f / (W8SCALE * H8SCALE)}; \
        pg8::gemm_phase<pg8::EpiStore, pg8::MoeOrder, 1>(ldsl + RING_OFF, g, S, E); } while (0)
    if (IN(14)) { PHASE_BEGIN(); MOE_GU(0); GRID_BAR(); }
    if (IN(15)) { PHASE_BEGIN(); MOE_DN(0); MOE_GU(1); GRID_BAR(); }
    if (IN(16)) { PHASE_BEGIN(); MOE_DN(1); MOE_GU(2); GRID_BAR(); }
    if (IN(17)) { PHASE_BEGIN(); MOE_DN(2); MOE_GU(3); GRID_BAR(); }
    if (IN(18)) { PHASE_BEGIN(); MOE_DN(3); MOE_GU(4); GRID_BAR(); }
    if (IN(19)) { PHASE_BEGIN(); MOE_DN(4); GRID_BAR(); }
    if (IN(24)) { PHASE_BEGIN();
        const RowVec wn = load_vec(final_w, lane); const bf16* Y = (const bf16*)(ws + WS_Y);
        for (int b = 0; b < 2; ++b) {
            const RowVec g2 = load_vec(MODP(1, b, 5), lane);
            for (int m = gw; m < SEQ; m += 2 * NGW) {
                size_t rowu[2]; RowVec xu[2]; unsigned long long ya[2][4], yb[2][4]; float gau[2], gbu[2];
#pragma unroll
                for (int u = 0; u < 2; ++u) { rowu[u] = (size_t)b * SEQ + m + u * NGW;
                    const int s1 = TSLOT[rowu[u] * 2], s2 = TSLOT[rowu[u] * 2 + 1]; gau[u] = TOKG[rowu[u] * 2]; gbu[u] = TOKG[rowu[u] * 2 + 1];
                    const unsigned long long* y1 = (const unsigned long long*)(Y + (size_t)s1 * DM) + lane; const unsigned long long* y2 = (const unsigned long long*)(Y + (size_t)s2 * DM) + lane;
                    xu[u] = load_vec(xres + rowu[u] * DM, lane);
#pragma unroll
                    for (int j = 0; j < 4; ++j) { ya[u][j] = y1[64 * j]; yb[u][j] = y2[64 * j]; } }
#pragma unroll
                for (int u = 0; u < 2; ++u) { float ssq = 0.f; const float ga = gau[u], gb = gbu[u];
#pragma unroll
                    for (int j = 0; j < 4; ++j) { const unsigned long long a = ya[u][j], c = yb[u][j]; const unsigned a0 = (unsigned)a, a1 = (unsigned)(a >> 32), c0 = (unsigned)c, c1 = (unsigned)(c >> 32);
                        f32x4 yv; yv.x = ga * att::bf_lo(a0) + gb * att::bf_lo(c0); yv.y = ga * att::bf_hi(a0) + gb * att::bf_hi(c0); yv.z = ga * att::bf_lo(a1) + gb * att::bf_lo(c1); yv.w = ga * att::bf_hi(a1) + gb * att::bf_hi(c1);
                        xu[u].v[j] = xu[u].v[j] + g2.v[j] * yv; ssq += (xu[u].v[j].x * xu[u].v[j].x + xu[u].v[j].y * xu[u].v[j].y) + (xu[u].v[j].z * xu[u].v[j].z + xu[u].v[j].w * xu[u].v[j].w); }
                    const float rs = rsqrtf(wave_sum(ssq) * (1.0f / DM) + EPS); f32x4* o = (f32x4*)(xres + rowu[u] * DM) + lane;
#pragma unroll
                    for (int j = 0; j < 4; ++j) o[64 * j] = xu[u].v[j] * rs * wn.v[j]; } }
        }
    }
#undef IN
#undef GRID_BAR
}

extern "C" void kernel_launch(void* const* d_in, const int* in_sizes, int n_in, void* d_out, int out_size, void* d_ws, size_t ws_size, hipStream_t stream) {
    static int grid = 0;
    if (grid == 0) {
        if (n_in != 29 || in_sizes[0] != T * DM || out_size != T * DM || ws_size < WS_END) { fprintf(stderr, "kernel_launch: shape/workspace mismatch (n_in %d, in0 %d, out %d, ws %zu, need %zu)\n", n_in, n_in > 0 ? in_sizes[0] : -1, out_size, ws_size, (size_t)WS_END); grid = -1; return; }
        int dev = 0, cus = 0;
        if (hipGetDevice(&dev) != hipSuccess || hipDeviceGetAttribute(&cus, hipDeviceAttributeMultiprocessorCount, dev) != hipSuccess) { grid = -1; return; }
        if (hipFuncSetAttribute((const void*)fwd_kernel, hipFuncAttributeMaxDynamicSharedMemorySize, LDS_BYTES) != hipSuccess) { fprintf(stderr, "kernel_launch: hipFuncSetAttribute failed\n"); grid = -1; return; }
        int per_cu = 0;
        if (hipOccupancyMaxActiveBlocksPerMultiprocessor(&per_cu, (const void*)fwd_kernel, NWAVES * 64, LDS_BYTES) != hipSuccess || per_cu < 1) fprintf(stderr, "kernel_launch: occupancy query reports %d\n", per_cu);
        (void)hipGetLastError();
        grid = cus;
        if (grid != 256) fprintf(stderr, "kernel_launch: %d CUs (built for 256)\n", grid);
    }
    if (grid < 0) return;
    if (hipMemsetAsync((char*)d_ws + WS_CTL, 0, CTL_ZERO_BYTES, stream) != hipSuccess) return;
    Args a{};
    for (int i = 0; i < 29; ++i) a.in[i] = (const float*)d_in[i];
    a.out = (float*)d_out; a.ws = (unsigned char*)d_ws;
#if MK_N_LAUNCHES == 1
    a.ph_lo = 0; a.ph_hi = N_PHASES;
    hipLaunchKernelGGL(fwd_kernel, dim3(grid), dim3(NWAVES * 64), LDS_BYTES, stream, a);
#else
#ifndef PROBE_SEQ
#define PROBE_SEQ 0,1,2,3,4,5,6,7,8,9,10,11,12,13,14,15,16,17,18,19,20,21,22,23,24
#endif
    { const int seq[] = {PROBE_SEQ}; for (int p : seq) { a.ph_lo = p; a.ph_hi = p + 1; hipLaunchKernelGGL(fwd_kernel, dim3(grid), dim3(NWAVES * 64), LDS_BYTES, stream, a); } }
#endif
    const hipError_t le = hipPeekAtLastError();
    if (le != hipSuccess) fprintf(stderr, "kernel_launch: launch failed: %s\n", hipGetErrorName(le));
}
```
